# Optimizing an MI355X kernel written in HIP

```python
import jax, jax.numpy as jnp
from jax import lax
import numpy as np

D_MODEL = 1024
BATCH = 4
SEQ = 8192
DEPTH = 4

HG_HEADS = 4
HG_DK = 128
HG_DV = 128
HG_CHUNK = 64
HG_QK = HG_HEADS * HG_DK
HG_W = HG_HEADS * HG_DV
SG_GROUPS = 4
SG_CHUNK = 128
SG_W = 512
SG_GW = SG_W // SG_GROUPS
AT_QHEADS = 8
AT_KVHEADS = 2
AT_HD = 64
AT_WINDOW = 128
AT_BLOCK = 128
AT_W = AT_QHEADS * AT_HD
AT_KVW = AT_KVHEADS * AT_HD
ROPE_THETA = 10000.0
N_BRANCH = 3
EPS = 1e-6
N_IN = 3 * HG_QK + 2 * HG_W + 3 * SG_W + 2 * AT_W + 2 * AT_KVW + N_BRANCH * D_MODEL

kernel_name = 'hybrid_hgrn2_gmlp_swa_gated_block'


def _split_sizes():
    return [HG_QK, HG_QK, HG_QK, HG_W, HG_W, SG_W, SG_W, SG_W,
            AT_W, AT_KVW, AT_KVW, AT_W, D_MODEL, D_MODEL, D_MODEL]


def rms_norm(x, g):
    xf = x.astype(jnp.float32)
    y = xf * lax.rsqrt(jnp.mean(xf * xf, axis=-1, keepdims=True) + EPS)
    return (y * g.astype(jnp.float32)).astype(x.dtype)


def layer_norm(x, g, b):
    xf = x.astype(jnp.float32)
    mu = jnp.mean(xf, axis=-1, keepdims=True)
    var = jnp.mean(jnp.square(xf - mu), axis=-1, keepdims=True)
    y = (xf - mu) * lax.rsqrt(var + EPS) * g.astype(jnp.float32) + b.astype(jnp.float32)
    return y.astype(x.dtype)


def rope_tables(L):
    half = AT_HD // 2
    inv_freq = ROPE_THETA ** (-jnp.arange(half, dtype=jnp.float32) / half)
    ang = jnp.arange(L, dtype=jnp.float32)[:, None] * inv_freq[None, :]
    return jnp.cos(ang)[None, :, None, :], jnp.sin(ang)[None, :, None, :]


def apply_rope(x, cos, sin):
    x1, x2 = jnp.split(x.astype(jnp.float32), 2, axis=-1)
    y = jnp.concatenate([x1 * cos - x2 * sin, x2 * cos + x1 * sin], axis=-1)
    return y.astype(x.dtype)


def hgrn2_gates(a, lb):
    a = a.astype(jnp.float32)
    log_f = jnp.logaddexp(jnp.log(lb), jnp.log1p(-lb) + jax.nn.log_sigmoid(a))
    k = (1.0 - lb) * jax.nn.sigmoid(-a)
    return log_f, k


def hgrn2_bidirectional(q, a_fwd, a_bwd, i, lb):
    B, L, _ = q.shape
    H, C = HG_HEADS, HG_CHUNK
    n_chunks = L // C
    lf_f, k_f = hgrn2_gates(a_fwd, lb[0])
    lf_b, k_b = hgrn2_gates(a_bwd, lb[1])

    def heads(t, d):
        return t.astype(jnp.float32).reshape(B, L, H, d)

    qh, vh = heads(q, HG_DK), heads(i, HG_DV)
    q2 = jnp.concatenate([qh, qh[:, ::-1]], axis=2)
    v2 = jnp.concatenate([vh, vh[:, ::-1]], axis=2)
    k2 = jnp.concatenate([heads(k_f, HG_DK), heads(k_b, HG_DK)[:, ::-1]], axis=2)
    lf2 = jnp.concatenate([heads(lf_f, HG_DK), heads(lf_b, HG_DK)[:, ::-1]], axis=2)

    def to_chunks(t):
        return t.reshape(B, n_chunks, C, 2 * H, t.shape[-1]).transpose(1, 0, 3, 2, 4)

    tri = jnp.tril(jnp.ones((C, C), dtype=bool))

    def step(S, xs):
        qc, kc, vc, lfc = xs
        b = jnp.cumsum(lfc, axis=2)
        diff = b[:, :, :, None, :] - b[:, :, None, :, :]
        decay = jnp.exp(jnp.where(tri[None, None, :, :, None], diff, -jnp.inf))
        scores = jnp.einsum('bhtd,bhtsd,bhsd->bhts', qc, decay, kc)
        o = jnp.einsum('bhts,bhsv->bhtv', scores, vc) + jnp.einsum('bhtd,bhdv->bhtv', qc * jnp.exp(b), S)
        b_end = b[:, :, -1, :]
        S_new = jnp.exp(b_end)[..., None] * S + jnp.einsum(
            'bhsd,bhsv->bhdv', kc * jnp.exp(b_end[:, :, None, :] - b), vc)
        return S_new, o

    S0 = jnp.zeros((B, 2 * H, HG_DK, HG_DV), jnp.float32)
    _, o = lax.scan(step, S0, (to_chunks(q2), to_chunks(k2), to_chunks(v2), to_chunks(lf2)))
    o = o.transpose(1, 0, 3, 2, 4).reshape(B, L, 2 * H, HG_DV)
    return o[:, :, :H] + o[:, ::-1, H:]


def spatial_gating(u, v, ln_g, ln_b, w_s, b_s):
    B, L, _ = u.shape
    vn = layer_norm(v, ln_g, ln_b).reshape(B, L // SG_CHUNK, SG_CHUNK, SG_GROUPS, SG_GW)
    mixed = jnp.einsum('gts,bnsgc->bntgc', w_s, vn) + b_s.T[None, None, :, :, None]
    return u * mixed.reshape(B, L, SG_W)


def window_attention(q, k, v, sink):
    B, L, _, _ = q.shape
    nb = L // AT_BLOCK
    G = AT_QHEADS // AT_KVHEADS
    qb = q.reshape(B, nb, AT_BLOCK, AT_KVHEADS, G, AT_HD)
    pad = ((0, 0), (AT_BLOCK, AT_BLOCK), (0, 0), (0, 0))

    def band(t):
        tp = jnp.pad(t, pad).reshape(B, nb + 2, AT_BLOCK, AT_KVHEADS, AT_HD)
        return jnp.concatenate([tp[:, :-2], tp[:, 1:-1], tp[:, 2:]], axis=2)

    kw, vw = band(k), band(v)
    blk = jnp.arange(nb)[:, None] * AT_BLOCK
    qpos = blk + jnp.arange(AT_BLOCK)[None, :]
    kpos = blk - AT_BLOCK + jnp.arange(3 * AT_BLOCK)[None, :]
    rel = kpos[:, None, :] - qpos[:, :, None]
    mask = (jnp.abs(rel) <= AT_WINDOW) & ((kpos >= 0) & (kpos < L))[:, None, :]
    s = jnp.einsum('bnqhgd,bnkhd->bnhgqk', qb, kw).astype(jnp.float32) * (AT_HD ** -0.5)
    s = jnp.where(mask[None, :, None, None], s, -jnp.inf)
    sk = sink.astype(jnp.float32).reshape(AT_KVHEADS, G)[None, None, :, :, None, None]
    m = jnp.maximum(jnp.max(s, axis=-1, keepdims=True), sk)
    p = jnp.exp(s - m)
    w = p / (jnp.sum(p, axis=-1, keepdims=True) + jnp.exp(sk - m))
    o = jnp.einsum('bnhgqk,bnkhd->bnqhgd', w.astype(v.dtype), vw)
    return o.reshape(B, L, AT_W)


def setup_inputs(seed: int = 0) -> dict:
    key = jax.random.key(seed)
    ks = jax.random.split(key, 16)
    f32 = jnp.float32
    nrm = lambda k, shape, scale: jax.random.normal(k, shape, f32) * scale
    return {
        'x': jax.random.normal(ks[0], (BATCH, SEQ, D_MODEL), f32),
        'w_in': nrm(ks[1], (DEPTH, D_MODEL, N_IN), D_MODEL ** -0.5),
        'norm_gain': 1.0 + nrm(ks[2], (DEPTH, D_MODEL), 0.02),
        'lb_logits': nrm(ks[3], (DEPTH, 2 * HG_QK), 1.0),
        'hg_norm_gain': 1.0 + nrm(ks[4], (DEPTH, HG_HEADS, HG_DV), 0.02),
        'sg_ln_gain': 1.0 + nrm(ks[5], (DEPTH, SG_W), 0.02),
        'sg_ln_bias': nrm(ks[6], (DEPTH, SG_W), 0.02),
        'w_spatial': nrm(ks[7], (DEPTH, SG_GROUPS, SG_CHUNK, SG_CHUNK), SG_CHUNK ** -0.5),
        'b_spatial': 1.0 + nrm(ks[8], (DEPTH, SG_GROUPS, SG_CHUNK), 0.02),
        'q_norm_gain': 1.0 + nrm(ks[9], (DEPTH, AT_HD), 0.02),
        'k_norm_gain': 1.0 + nrm(ks[10], (DEPTH, AT_HD), 0.02),
        'sink_logits': nrm(ks[11], (DEPTH, AT_QHEADS), 0.5),
        'w_branch_a': nrm(ks[12], (DEPTH, HG_W, D_MODEL), HG_W ** -0.5),
        'w_branch_b': nrm(ks[13], (DEPTH, SG_W, D_MODEL), SG_W ** -0.5),
        'w_branch_c': nrm(ks[14], (DEPTH, AT_W, D_MODEL), AT_W ** -0.5),
        'w_out': nrm(ks[15], (DEPTH, D_MODEL, D_MODEL), D_MODEL ** -0.5),
    }


def reference(x, w_in, norm_gain, lb_logits, hg_norm_gain, sg_ln_gain, sg_ln_bias, w_spatial, b_spatial,
              q_norm_gain, k_norm_gain, sink_logits, w_branch_a, w_branch_b, w_branch_c, w_out):
    B, L, _ = x.shape
    cos, sin = rope_tables(L)
    split_at = np.cumsum(_split_sizes())[:-1].tolist()
    p_lb = jax.nn.softmax(lb_logits.astype(jnp.float32), axis=0)
    lower = jnp.maximum(jnp.cumsum(p_lb, axis=0) - p_lb[0:1], 0.0).reshape(DEPTH, 2, HG_QK)

    for l in range(DEPTH):
        h = rms_norm(x, norm_gain[l])
        proj = jnp.einsum('bld,dn->bln', h, w_in[l])
        (qa, fa_f, fa_b, ia, za, ub, vb, zb, qc, kc, vc, zc,
         g_a, g_b, g_c) = jnp.split(proj, split_at, axis=-1)

        ya = hgrn2_bidirectional(qa, fa_f, fa_b, ia, lower[l]).astype(x.dtype)
        ya = rms_norm(ya, hg_norm_gain[l]).reshape(B, L, HG_W) * jax.nn.silu(za)

        yb = spatial_gating(jax.nn.gelu(ub), jax.nn.gelu(vb), sg_ln_gain[l], sg_ln_bias[l],
                            w_spatial[l], b_spatial[l]) * jax.nn.silu(zb)

        qh = apply_rope(rms_norm(qc.reshape(B, L, AT_QHEADS, AT_HD), q_norm_gain[l]), cos, sin)
        kh = apply_rope(rms_norm(kc.reshape(B, L, AT_KVHEADS, AT_HD), k_norm_gain[l]), cos, sin)
        vh = vc.reshape(B, L, AT_KVHEADS, AT_HD)
        yc = window_attention(qh, kh, vh, sink_logits[l]) * jax.nn.silu(zc)

        merged = (jax.nn.sigmoid(g_a) * jnp.einsum('blw,wd->bld', ya, w_branch_a[l])
                  + jax.nn.sigmoid(g_b) * jnp.einsum('blw,wd->bld', yb, w_branch_b[l])
                  + jax.nn.sigmoid(g_c) * jnp.einsum('blw,wd->bld', yc, w_branch_c[l]))
        x = x + jnp.einsum('bld,de->ble', merged, w_out[l])
    return x
```

```cpp
#include <hip/hip_runtime.h>
#include <hip/hip_cooperative_groups.h>
#include <cstdio>
namespace cg = cooperative_groups;

#define LAS __attribute__((address_space(3)))
#define DI __device__ __forceinline__
typedef unsigned short bf16_t;
typedef short bf16x8 __attribute__((ext_vector_type(8)));
typedef short bf16x4 __attribute__((ext_vector_type(4)));
typedef float f32x4 __attribute__((ext_vector_type(4)));
typedef float f32x2 __attribute__((ext_vector_type(2)));
typedef unsigned u32x4 __attribute__((ext_vector_type(4)));
typedef unsigned u32x2 __attribute__((ext_vector_type(2)));
typedef __bf16 bfv2 __attribute__((ext_vector_type(2)));

constexpr int T_TOK = 32768, SEQ = 8192, DM = 1024, DEPTH = 4;
constexpr int NP = 5376;
constexpr int NIN = 8448;
constexpr float EPS = 1e-6f;
constexpr int C_QA = 0, C_IA = 512, C_LFF = 1024, C_LFB = 1536, C_ZA = 2048, C_UB = 2560, C_ZB = 3072, C_VB = 3584,
              C_QC = 4096, C_ZC = 4608, C_KC = 5120, C_VC = 5248;
constexpr int C_MERGED = 1024;
constexpr int C_GSCR = 3072;

constexpr size_t WS_PROJ = 0;
constexpr size_t WS_XB   = WS_PROJ + (size_t)T_TOK * NP * 2;
constexpr size_t WS_WIN  = WS_XB + (size_t)T_TOK * DM * 2;
constexpr size_t WS_WG   = WS_WIN + (size_t)NP * DM * 2;
constexpr size_t WS_WBR  = WS_WG + (size_t)3072 * DM * 2;
constexpr size_t WS_WOUT = WS_WBR + (size_t)3 * 1024 * 512 * 2;
constexpr size_t WS_ST   = WS_WOUT + (size_t)1024 * 1024 * 2;
constexpr size_t WS_DD   = WS_ST + (size_t)32 * 32 * 16384 * 4;
constexpr size_t WS_SSQ  = WS_DD + (size_t)32 * 32 * 128 * 4;
constexpr size_t WS_ROPE = WS_SSQ + (size_t)16 * T_TOK * 4;
constexpr size_t WS_LB   = WS_ROPE + (size_t)SEQ * 64 * 4;
constexpr size_t WS_BAR  = WS_LB + (size_t)DEPTH * 1024 * 4;
constexpr size_t WS_END  = WS_BAR + (size_t)3456 * 4;

constexpr int LDS_BYTES = 148 * 1024;
constexpr int LDS_RSB = 128 * 1024;
constexpr int LDS_XB = LDS_BYTES - 16;

struct Params {
  const float* x; const float* w_in; const float* norm_gain; const float* lb_logits; const float* hg_gain;
  const float* sg_g; const float* sg_b; const float* w_sp; const float* b_sp; const float* qg; const float* kg;
  const float* sink; const float* wba; const float* wbb; const float* wbc; const float* w_out;
  float* out; unsigned char* ws;
  int use_cg_sync; int pad0;
};

DI unsigned pk_bf16(float lo, float hi) { f32x2 v = {lo, hi}; bfv2 b = __builtin_convertvector(v, bfv2); return __builtin_bit_cast(unsigned, b); }
DI bf16_t f2bf(float f) { return (bf16_t)(pk_bf16(f, 0.f) & 0xffffu); }
DI float bf2f(unsigned short b) { return __uint_as_float(((unsigned)b) << 16); }
DI float bflo(unsigned w) { return __uint_as_float(w << 16); }
DI float bfhi(unsigned w) { return __uint_as_float(w & 0xffff0000u); }
DI unsigned short f2h(float f) { _Float16 h = (_Float16)f; return __builtin_bit_cast(unsigned short, h); }
DI float h2f(unsigned short u) { _Float16 h = __builtin_bit_cast(_Float16, u); return (float)h; }
DI float fsigmoid(float v) { return __builtin_amdgcn_rcpf(1.0f + __builtin_amdgcn_exp2f(v * -1.4426950408889634f)); }
DI float fsilu(float v) { return v * __builtin_amdgcn_rcpf(1.0f + __builtin_amdgcn_exp2f(v * -1.4426950408889634f)); }
DI float fgelu(float v) { return v * __builtin_amdgcn_rcpf(1.0f + __builtin_amdgcn_exp2f(v * (-2.3022082f - 0.1029432f * v * v))); }
DI float row_rs(const float* ssqp, int r, int fq) {
  const f32x4 a = *(const f32x4*)(ssqp + (size_t)r * 16 + fq * 4);
  float t = (a[0] + a[1]) + (a[2] + a[3]);
  t += __shfl_xor(t, 16); t += __shfl_xor(t, 32);
  return rsqrtf(t * (1.0f / 1024.0f) + EPS); }
DI float row_rs_lds(const LAS unsigned char* lds, int rl, int fq) {
  const f32x4 a = *(const LAS f32x4*)(lds + LDS_RSB + rl * 64 + fq * 16);
  float t = (a[0] + a[1]) + (a[2] + a[3]);
  t += __shfl_xor(t, 16); t += __shfl_xor(t, 32);
  return rsqrtf(t * (1.0f / 1024.0f) + EPS); }
DI f32x4 mfma16(bf16x8 a, bf16x8 b, f32x4 c) { return __builtin_amdgcn_mfma_f32_16x16x32_bf16(a, b, c, 0, 0, 0); }

DI void lds_barrier() { asm volatile("s_waitcnt lgkmcnt(0)" ::: "memory"); __builtin_amdgcn_s_barrier(); asm volatile("" ::: "memory"); }
DI int opaque_tid() { int t = threadIdx.x; asm volatile("" : "+v"(t)); return t; }
constexpr int BM = 256, BK = 64, HALF = 128, HTB = HALF * BK * 2, NXCD = 8, WGM = 8;
DI int lds_byte(int r, int c) { const int st = (r >> 4) * 2 + (c >> 5), rr = r & 15, cc = c & 31, ob = rr * 64 + cc * 2; return st * 1024 + (ob ^ (((ob >> 9) & 1) << 5)); }
DI void stage_rc(int b, int& R, int& C) { const int st = b / 1024, sb = b % 1024, swz = sb ^ (((sb >> 9) & 1) << 5); R = (st >> 1) * 16 + swz / 64; C = (st & 1) * 32 + (swz % 64) / 2; }
DI int perm32(int rho) { const int n = rho >> 4, i = rho & 15; return 8 * (i >> 2) + 4 * n + (i & 3); }

struct GUnit { const char* A; const char* B; int lda2, ldb2, nt, pm, pn, mode; };

DI void tile_order(int L, int nM, int nN, int& pm, int& pn) {
  const int nwg = nM * nN; int wgid = L;
  { const int q = nwg / NXCD, r = nwg % NXCD, xcd = wgid % NXCD, off = wgid / NXCD; wgid = (xcd < r ? xcd * (q + 1) : r * (q + 1) + (xcd - r) * q) + off; }
  const int nig = WGM * nN, gid = wgid / nig, fm = gid * WGM, gsz = (nM - fm) < WGM ? (nM - fm) : WGM;
  pm = fm + ((wgid % nig) % gsz); pn = (wgid % nig) / gsz;
}

template <int RSMODE  , class Gen, class Epi>
DI void gemm_phase(LAS unsigned char* lds, const Gen& gen, const Epi& E, const float* ssqg) {
  const int tid = opaque_tid(), wid = __builtin_amdgcn_readfirstlane(tid >> 6), lane = tid & 63, wr = wid >> 2, wc = wid & 3, fr = lane & 15, fq = lane >> 4;
  int RA[2], RB[2], CC[2];
#pragma unroll
  for (int i = 0; i < 2; ++i) { int R, C; stage_rc(tid * 16 + i * 8192, R, C); RA[i] = R; RB[i] = (R & ~31) + perm32(R & 31); CC[i] = C * 2; }
  const unsigned ldsw = (unsigned)wid * 1024u;
  const int aoff = lds_byte(wr * 64 + fr, fq * 8), boff = lds_byte(wc * 32 + fr, fq * 8);
#define G_SA(b, h) (((b) * 2 + (h)) * HTB)
#define G_SB(b, h) ((4 + (b) * 2 + (h)) * HTB)
#define G_STAGEA(bufoff, gbase, ld2) do { _Pragma("unroll") for (int _i = 0; _i < 2; ++_i) \
    __builtin_amdgcn_global_load_lds((const unsigned*)((gbase) + (unsigned)(RA[_i] * (ld2) + CC[_i])), (LAS unsigned*)(lds + (bufoff) + ldsw + _i * 8192), 16, 0, 0); } while (0)
#define G_STAGEB(bufoff, gbase, ld2) do { _Pragma("unroll") for (int _i = 0; _i < 2; ++_i) \
    __builtin_amdgcn_global_load_lds((const unsigned*)((gbase) + (unsigned)(RB[_i] * (ld2) + CC[_i])), (LAS unsigned*)(lds + (bufoff) + ldsw + _i * 8192), 16, 0, 0); } while (0)
#define G_LDA(dst, b, h) do { _Pragma("unroll") for (int m = 0; m < 4; ++m) _Pragma("unroll") for (int k = 0; k < 2; ++k) dst[m][k] = *(const LAS bf16x8*)(lds + G_SA(b, h) + aoff + m * 2048 + k * 1024); } while (0)
#define G_LDB(dst, b, h) do { _Pragma("unroll") for (int n = 0; n < 2; ++n) _Pragma("unroll") for (int k = 0; k < 2; ++k) dst[n][k] = *(const LAS bf16x8*)(lds + G_SB(b, h) + boff + n * 2048 + k * 1024); } while (0)
#define G_MMA(ai, bj, At, Bt) do { __builtin_amdgcn_s_setprio(1); _Pragma("unroll") for (int m = 0; m < 4; ++m) _Pragma("unroll") for (int n = 0; n < 2; ++n) _Pragma("unroll") for (int k = 0; k < 2; ++k) \
    acc[ai][bj][m][n] = __builtin_amdgcn_mfma_f32_16x16x32_bf16(Bt[n][k], At[m][k], acc[ai][bj][m][n], 0, 0, 0); __builtin_amdgcn_s_setprio(0); } while (0)
#define G_WAIT_V(n) asm volatile("s_waitcnt vmcnt(" #n ")" ::: "memory")
#define G_WAIT_L(n) asm volatile("s_waitcnt lgkmcnt(" #n ")" ::: "memory")
#define G_BAR __builtin_amdgcn_s_barrier()
#define G_SCHED __builtin_amdgcn_sched_barrier(0)
  GUnit cur, nxt; int ui = 0;
  if (!gen.get(0, cur)) return;
  f32x4 acc[2][2][4][2];
#pragma unroll
  for (int a = 0; a < 2; ++a)
#pragma unroll
    for (int b = 0; b < 2; ++b)
#pragma unroll
      for (int m = 0; m < 4; ++m)
#pragma unroll
        for (int n = 0; n < 2; ++n) acc[a][b][m][n] = (f32x4){0.f, 0.f, 0.f, 0.f};
  bf16x8 At[4][2], B0[2][2], B1[2][2];
  const char* cA = cur.A; const char* cB = cur.B; int clda = cur.lda2, cldb = cur.ldb2;
  constexpr size_t kstep = BK * 2;
  G_STAGEB(G_SB(0, 0), cB, cldb); G_STAGEA(G_SA(0, 0), cA, clda); G_STAGEB(G_SB(0, 1), cB + (size_t)HALF * cldb, cldb); G_STAGEA(G_SA(0, 1), cA + (size_t)HALF * clda, clda);
  if (wr == 1) G_BAR;
  G_WAIT_V(4); G_BAR;
  G_STAGEB(G_SB(1, 0), cB + kstep, cldb); G_STAGEA(G_SA(1, 0), cA + kstep, clda); G_STAGEB(G_SB(1, 1), cB + (size_t)HALF * cldb + kstep, cldb);
  G_WAIT_V(6); G_BAR;
  for (;;) {
    const bool has_next = gen.get(ui + 1, nxt);
    const char* nA = has_next ? nxt.A : cA; const char* nB = has_next ? nxt.B : cB;
    const int nlda = has_next ? nxt.lda2 : clda, nldb = has_next ? nxt.ldb2 : cldb;
    const int nt = cur.nt;
    for (int t = 0; t < nt; t += 2) {
      const bool last = (t == nt - 2);
      const char* a1 = cA + (size_t)(t + 1) * kstep;
      const char* a2 = last ? nA : cA + (size_t)(t + 2) * kstep; const char* b2 = last ? nB : cB + (size_t)(t + 2) * kstep;
      const int lda_n = last ? nlda : clda, ldb_n = last ? nldb : cldb;
      const char* a3 = a2 + kstep; const char* b3 = b2 + kstep;
      G_LDB(B0, 0, 0); G_SCHED; G_LDA(At, 0, 0); G_STAGEA(G_SA(1, 1), a1 + (size_t)HALF * clda, clda);
      if (RSMODE != 0 && t == 2 && (RSMODE == 1 || cur.mode == 0)) {
        const char* rsrc = (const char*)ssqg + (size_t)cur.pm * (BM * 64) + ldsw + (unsigned)lane * 16u;
#pragma unroll
        for (int _i = 0; _i < 2; ++_i) __builtin_amdgcn_global_load_lds((const unsigned*)(rsrc + _i * 8192), (LAS unsigned*)(lds + LDS_RSB + ldsw + _i * 8192), 16, 0, 0);
      }
      G_WAIT_L(8); G_BAR; G_WAIT_L(0); G_MMA(0, 0, At, B0); G_BAR; G_SCHED;
      G_LDB(B1, 0, 1); G_STAGEB(G_SB(0, 0), b2, ldb_n);
      G_BAR; G_WAIT_L(0); G_MMA(0, 1, At, B1); G_BAR;
      G_LDA(At, 0, 1); G_STAGEA(G_SA(0, 0), a2, lda_n);
      G_BAR; G_WAIT_L(0); G_MMA(1, 0, At, B0); G_BAR; G_SCHED;
      G_STAGEB(G_SB(0, 1), b2 + (size_t)HALF * ldb_n, ldb_n);
      G_WAIT_V(6); G_BAR; G_MMA(1, 1, At, B1); G_BAR;
      G_LDB(B0, 1, 0); G_SCHED; G_LDA(At, 1, 0); G_STAGEA(G_SA(0, 1), a2 + (size_t)HALF * lda_n, lda_n);
      G_WAIT_L(8); G_BAR; G_WAIT_L(0); G_MMA(0, 0, At, B0); G_BAR; G_SCHED;
      G_LDB(B1, 1, 1); G_STAGEB(G_SB(1, 0), b3, ldb_n);
      G_BAR; G_WAIT_L(0); G_MMA(0, 1, At, B1); G_BAR;
      G_LDA(At, 1, 1); G_STAGEA(G_SA(1, 0), a3, lda_n);
      G_BAR; G_WAIT_L(0); G_MMA(1, 0, At, B0); G_BAR; G_SCHED;
      G_STAGEB(G_SB(1, 1), b3 + (size_t)HALF * ldb_n, ldb_n);
      G_WAIT_V(6); G_BAR; G_MMA(1, 1, At, B1); G_BAR;
    }
    E(acc, cur, wr, wc, fr, fq, lds);
    if (!has_next) break;
#pragma unroll
    for (int a = 0; a < 2; ++a)
#pragma unroll
      for (int b = 0; b < 2; ++b)
#pragma unroll
        for (int m = 0; m < 4; ++m)
#pragma unroll
          for (int n = 0; n < 2; ++n) acc[a][b][m][n] = (f32x4){0.f, 0.f, 0.f, 0.f};
    cur = nxt; cA = nA; cB = nB; clda = nlda; cldb = nldb; ++ui;
  }
  G_WAIT_V(0);
  if (wr == 0) G_BAR;
  G_BAR;
#undef G_SA
#undef G_SB
#undef G_STAGEA
#undef G_STAGEB
#undef G_LDA
#undef G_LDB
#undef G_MMA
}

struct GenPlain {
  const char* A; const char* B; int lda2, ldb2, nt, nM, nN, G, c;
  DI bool get(int i, GUnit& u) const {
    const long L = (long)i * G + c; if (L >= (long)nM * nN) return false;
    int pm, pn; tile_order((int)L, nM, nN, pm, pn);
    u.A = A + (size_t)pm * BM * lda2; u.B = B + (size_t)pn * BM * ldb2; u.lda2 = lda2; u.ldb2 = ldb2; u.nt = nt; u.pm = pm; u.pn = pn; u.mode = 0; return true;
  }
};
struct GenMerge {
  const char* xb; const char* proj; const char* wg; const char* wbr; int G, c;
  DI bool get(int i, GUnit& u) const {
    const int ti = i / 6, sub = i - ti * 6, br = sub >> 1;
    const long L = (long)ti * G + c; if (L >= 512) return false;
    int pm, pn; tile_order((int)L, 128, 4, pm, pn);
    u.pm = pm; u.pn = pn;
    if ((sub & 1) == 0) { u.A = xb + (size_t)pm * BM * 2048; u.lda2 = 2048; u.B = wg + ((size_t)br * 1024 + (size_t)pn * BM) * 2048; u.ldb2 = 2048; u.nt = 16; u.mode = 0; }
    else { const int col = br == 0 ? C_QA : (br == 1 ? C_UB : C_QC);
      u.A = proj + (size_t)pm * BM * (NP * 2) + (size_t)col * 2; u.lda2 = NP * 2; u.B = wbr + ((size_t)br * 1024 + (size_t)pn * BM) * 1024; u.ldb2 = 1024; u.nt = 8; u.mode = br + 1; }
    return true;
  }
};

struct EpiProj {
  bf16_t* P; const float* ssq; const float* lb;
  DI void operator()(const f32x4 (&acc)[2][2][4][2], const GUnit& u, int wr, int wc, int fr, int fq, const LAS unsigned char* lds) const {
    const int row0 = u.pm * BM + wr * 64 + fr;
    float rs[2][4];
#pragma unroll
    for (int ai = 0; ai < 2; ++ai)
#pragma unroll
      for (int m = 0; m < 4; ++m) rs[ai][m] = row_rs_lds(lds, wr * 64 + fr + ai * HALF + m * 16, fq);
#pragma unroll
    for (int bj = 0; bj < 2; ++bj) {
      const int cb = u.pn * BM + bj * HALF; const int region = cb >> 9;
      const int col0 = cb + wc * 32 + 8 * fq;
      int act = 0;
      if (region == 2 || region == 3) act = 3;
      float lbv[8];
      if (act == 3) { const f32x4 l0 = *(const f32x4*)(lb + col0 - 1024), l1 = *(const f32x4*)(lb + col0 - 1024 + 4);
#pragma unroll
        for (int j = 0; j < 4; ++j) { lbv[j] = l0[j]; lbv[4 + j] = l1[j]; } }
#pragma unroll
      for (int ai = 0; ai < 2; ++ai)
#pragma unroll
        for (int m = 0; m < 4; ++m) {
          float v[8];
#pragma unroll
          for (int j = 0; j < 4; ++j) { v[j] = acc[ai][bj][m][0][j] * rs[ai][m]; v[4 + j] = acc[ai][bj][m][1][j] * rs[ai][m]; }
          u32x4 w;
          if (act == 3) {
            unsigned short hh[8];
#pragma unroll
            for (int j = 0; j < 8; ++j) { const float f = lbv[j] + (1.0f - lbv[j]) * fsigmoid(v[j]); hh[j] = f2h(fmaxf(__builtin_amdgcn_logf(f), -43.0f)); }
            w.x = hh[0] | ((unsigned)hh[1] << 16); w.y = hh[2] | ((unsigned)hh[3] << 16); w.z = hh[4] | ((unsigned)hh[5] << 16); w.w = hh[6] | ((unsigned)hh[7] << 16);
          } else {
            if (act == 1) {
#pragma unroll
              for (int j = 0; j < 8; ++j) v[j] = fsilu(v[j]);
            } else if (act == 2) {
#pragma unroll
              for (int j = 0; j < 8; ++j) v[j] = fgelu(v[j]);
            }
            w.x = pk_bf16(v[0], v[1]); w.y = pk_bf16(v[2], v[3]); w.z = pk_bf16(v[4], v[5]); w.w = pk_bf16(v[6], v[7]);
          }
          *(u32x4*)(P + (size_t)(row0 + ai * HALF + m * 16) * NP + col0) = w;
          asm volatile("" ::: "memory");
        }
    }
  }
};
struct EpiMerge {
  bf16_t* P; const float* ssq; unsigned char* scr;
  template <int MODE>
  DI void run(const f32x4 (&acc)[2][2][4][2], const GUnit& u, int wr, int wc, int fr, int fq, const LAS unsigned char* lds) const {
    const int row0 = u.pm * BM + wr * 64 + fr;
    unsigned voff = (unsigned)((wr * 4 + wc) * 64 + fq * 16 + fr) * 8u; asm volatile("" : "+v"(voff));
#pragma unroll
    for (int ai = 0; ai < 2; ++ai) {
      u32x2 g[4][2]; u32x4 mm[4][2];
      if (MODE >= 1) {
#pragma unroll
        for (int m = 0; m < 4; ++m)
#pragma unroll
          for (int bj = 0; bj < 2; ++bj) { const int q = (ai * 4 + m) * 2 + bj;
            g[m][bj] = *(const u32x2*)((scr + 131072 + q * 4096) + voff);
            if (MODE >= 2) mm[m][bj] = *(const u32x4*)((scr + q * 8192) + voff * 2u); }
      }
#pragma unroll
      for (int m = 0; m < 4; ++m) {
        const int r = row0 + ai * HALF + m * 16;
        float rsv = 0.f; if (MODE == 0) rsv = row_rs_lds(lds, wr * 64 + fr + ai * HALF + m * 16, fq);
#pragma unroll
        for (int bj = 0; bj < 2; ++bj) {
          const int q = (ai * 4 + m) * 2 + bj;
          u32x2* gp = (u32x2*)((scr + 131072 + q * 4096) + voff); u32x4* mp = (u32x4*)((scr + q * 8192) + voff * 2u);
          if (MODE == 0) {
            u32x2 w = {0u, 0u};
#pragma unroll
            for (int j = 0; j < 4; ++j) {
              w.x |= (unsigned)__float2uint_rn(fsigmoid(acc[ai][bj][m][0][j] * rsv) * 255.0f) << (8 * j);
              w.y |= (unsigned)__float2uint_rn(fsigmoid(acc[ai][bj][m][1][j] * rsv) * 255.0f) << (8 * j); }
            *gp = w;
          } else {
            const u32x2 gg = g[m][bj];
            float v[8];
#pragma unroll
            for (int j = 0; j < 4; ++j) { v[j] = acc[ai][bj][m][0][j] * ((float)((gg.x >> (8 * j)) & 0xffu) * (1.0f / 255.0f)); v[4 + j] = acc[ai][bj][m][1][j] * ((float)((gg.y >> (8 * j)) & 0xffu) * (1.0f / 255.0f)); }
            if (MODE >= 2) { const u32x4 mv = mm[m][bj];
              v[0] += bflo(mv.x); v[1] += bfhi(mv.x); v[2] += bflo(mv.y); v[3] += bfhi(mv.y); v[4] += bflo(mv.z); v[5] += bfhi(mv.z); v[6] += bflo(mv.w); v[7] += bfhi(mv.w); }
            u32x4 w; w.x = pk_bf16(v[0], v[1]); w.y = pk_bf16(v[2], v[3]); w.z = pk_bf16(v[4], v[5]); w.w = pk_bf16(v[6], v[7]);
            if (MODE == 3) *(u32x4*)(P + (size_t)r * NP + C_MERGED + u.pn * BM + bj * HALF + wc * 32 + 8 * fq) = w;
            else *mp = w;
          }
        }
      }
      asm volatile("" ::: "memory");
    }
  }
  DI void operator()(const f32x4 (&acc)[2][2][4][2], const GUnit& u, int wr, int wc, int fr, int fq, const LAS unsigned char* lds) const {
    if (u.mode == 0) run<0>(acc, u, wr, wc, fr, fq, lds); else if (u.mode == 1) run<1>(acc, u, wr, wc, fr, fq, lds); else if (u.mode == 2) run<2>(acc, u, wr, wc, fr, fq, lds); else run<3>(acc, u, wr, wc, fr, fq, lds);
  }
};
struct EpiOut {
  const float* XI; float* XO; bf16_t* XB; float* ssqn; int first, lastl;
  DI void operator()(const f32x4 (&acc)[2][2][4][2], const GUnit& u, int wr, int wc, int fr, int fq, const LAS unsigned char*) const {
    const int row0 = u.pm * BM + wr * 64 + fr;
#pragma unroll
    for (int ai = 0; ai < 2; ++ai)
#pragma unroll
      for (int mh = 0; mh < 2; ++mh) {
        f32x4 xa[2][2], xb2[2][2];
        if (first) {
#pragma unroll
          for (int mm = 0; mm < 2; ++mm)
#pragma unroll
            for (int bj = 0; bj < 2; ++bj) { const float* xi = XI + (size_t)(row0 + ai * HALF + (mh * 2 + mm) * 16) * DM + u.pn * BM + bj * HALF + wc * 32 + 8 * fq; xa[mm][bj] = *(const f32x4*)xi; xb2[mm][bj] = *(const f32x4*)(xi + 4); }
        } else {
          u32x4 xw[2][2];
#pragma unroll
          for (int mm = 0; mm < 2; ++mm)
#pragma unroll
            for (int bj = 0; bj < 2; ++bj) xw[mm][bj] = *(const u32x4*)(XB + (size_t)(row0 + ai * HALF + (mh * 2 + mm) * 16) * DM + u.pn * BM + bj * HALF + wc * 32 + 8 * fq);
#pragma unroll
          for (int mm = 0; mm < 2; ++mm)
#pragma unroll
            for (int bj = 0; bj < 2; ++bj) { xa[mm][bj] = (f32x4){bflo(xw[mm][bj].x), bfhi(xw[mm][bj].x), bflo(xw[mm][bj].y), bfhi(xw[mm][bj].y)}; xb2[mm][bj] = (f32x4){bflo(xw[mm][bj].z), bfhi(xw[mm][bj].z), bflo(xw[mm][bj].w), bfhi(xw[mm][bj].w)}; }
        }
#pragma unroll
        for (int mm = 0; mm < 2; ++mm) {
          const int m = mh * 2 + mm;
          const int r = row0 + ai * HALF + m * 16; float ss = 0.f;
#pragma unroll
          for (int bj = 0; bj < 2; ++bj) {
            const int col0 = u.pn * BM + bj * HALF + wc * 32 + 8 * fq;
            f32x4 x0 = xa[mm][bj] + acc[ai][bj][m][0], x1 = xb2[mm][bj] + acc[ai][bj][m][1];
            if (lastl) { float* xp = XO + (size_t)r * DM + col0; *(f32x4*)xp = x0; *(f32x4*)(xp + 4) = x1; }
            else {
              u32x4 w; w.x = pk_bf16(x0[0], x0[1]); w.y = pk_bf16(x0[2], x0[3]); w.z = pk_bf16(x1[0], x1[1]); w.w = pk_bf16(x1[2], x1[3]);
              *(u32x4*)(XB + (size_t)r * DM + col0) = w;
              ss += (x0[0] * x0[0] + x0[1] * x0[1]) + (x0[2] * x0[2] + x0[3] * x0[3]) + (x1[0] * x1[0] + x1[1] * x1[1]) + (x1[2] * x1[2] + x1[3] * x1[3]);
            }
          }
          if (!lastl) { ss += __shfl_xor(ss, 16); ss += __shfl_xor(ss, 32);
            if (fq == 0) ssqn[(size_t)r * 16 + u.pn * 4 + wc] = ss; }
        }
        asm volatile("" ::: "memory");
      }
  }
};

DI int inproj_orig_col(int n) {
  const int mb = n >> 7, w = n & 127; int ob;
  if (mb < 4) ob = mb; else if (mb < 8) ob = mb + 8; else if (mb < 16) ob = mb - 4; else if (mb < 24) ob = mb;
  else if (mb < 28) ob = mb + 4; else if (mb < 32) ob = mb - 4; else if (mb < 36) ob = mb; else if (mb < 40) ob = mb + 2; else ob = mb - 4;
  return ob * 128 + w;
}
DI void convert_w(const float* W, int ldw, int K, bf16_t* Wt, int Nn, int mapmode, int colbase, const float* gain, long gtid, long gthreads) {
  const long ntask = (long)Nn * (K / 8);
  for (long task0 = gtid; task0 < ntask; task0 += 2 * gthreads) {
    float v[2][8]; int k8s[2], ns[2]; bool ok[2];
#pragma unroll
    for (int u = 0; u < 2; ++u) {
      const long task = task0 + u * gthreads; ok[u] = task < ntask; const long tk = ok[u] ? task : task0;
      const int k8 = (int)(tk / Nn), n = (int)(tk - (long)k8 * Nn); k8s[u] = k8; ns[u] = n;
      const int oc = mapmode ? inproj_orig_col(n) : colbase + n;
#pragma unroll
      for (int i = 0; i < 8; ++i) v[u][i] = W[(size_t)(k8 * 8 + i) * ldw + oc];
    }
#pragma unroll
    for (int u = 0; u < 2; ++u) {
      const int k8 = k8s[u], n = ns[u];
      if (gain) { const f32x4 g0 = *(const f32x4*)(gain + k8 * 8), g1 = *(const f32x4*)(gain + k8 * 8 + 4);
#pragma unroll
        for (int i = 0; i < 4; ++i) { v[u][i] *= g0[i]; v[u][4 + i] *= g1[i]; } }
      u32x4 w; w.x = pk_bf16(v[u][0], v[u][1]); w.y = pk_bf16(v[u][2], v[u][3]); w.z = pk_bf16(v[u][4], v[u][5]); w.w = pk_bf16(v[u][6], v[u][7]);
      if (ok[u]) *(u32x4*)(Wt + (size_t)n * K + k8 * 8) = w;
    }
  }
}

typedef short s16x4 __attribute__((ext_vector_type(4)));
DI bf16x8 tr_pair(const LAS bf16_t* p0, const LAS bf16_t* p1) {
  const s16x4 a = __builtin_amdgcn_ds_read_tr16_b64_v4i16((LAS s16x4*)p0), b = __builtin_amdgcn_ds_read_tr16_b64_v4i16((LAS s16x4*)p1);
  return (bf16x8){a[0], a[1], a[2], a[3], b[0], b[1], b[2], b[3]};
}
constexpr int SG_LD = 272;
DI void sgu_item(LAS unsigned char* lds, const Params& p, int l, int item) {
  bf16_t* P = (bf16_t*)(p.ws + WS_PROJ);
  const int tid = opaque_tid(), wid = __builtin_amdgcn_readfirstlane(tid >> 6), lane = tid & 63, fr = lane & 15, fq = lane >> 4;
  const size_t tok0 = (size_t)item * 128;
  LAS float* stat = (LAS float*)lds;
  LAS bf16_t* vn = (LAS bf16_t*)(lds + 1024);
  LAS float* lng = (LAS float*)(lds + 1024 + 128 * SG_LD * 2); LAS float* lnb = lng + 512;
  __syncthreads();
  lng[tid] = p.sg_g[l * 512 + tid]; lnb[tid] = p.sg_b[l * 512 + tid];
  {
    u32x4 w[16];
#pragma unroll
    for (int i = 0; i < 16; ++i) w[i] = *(const u32x4*)(P + (tok0 + wid * 16 + i) * NP + C_VB + lane * 8);
#pragma unroll
    for (int i = 0; i < 16; ++i) {
      const float v[8] = {fgelu(bflo(w[i].x)), fgelu(bfhi(w[i].x)), fgelu(bflo(w[i].y)), fgelu(bfhi(w[i].y)), fgelu(bflo(w[i].z)), fgelu(bfhi(w[i].z)), fgelu(bflo(w[i].w)), fgelu(bfhi(w[i].w))};
      float sm = 0.f;
#pragma unroll
      for (int j = 0; j < 8; ++j) sm += v[j];
#pragma unroll
      for (int o = 32; o >= 1; o >>= 1) sm += __shfl_xor(sm, o);
      const float mu = sm * (1.0f / 512.0f); float q = 0.f;
#pragma unroll
      for (int j = 0; j < 8; ++j) { const float d = v[j] - mu; q += d * d; }
#pragma unroll
      for (int o = 32; o >= 1; o >>= 1) q += __shfl_xor(q, o);
      if (lane == 0) { stat[(wid * 16 + i) * 2] = mu; stat[(wid * 16 + i) * 2 + 1] = rsqrtf(q * (1.0f / 512.0f) + EPS); }
    }
  }
  __syncthreads();
  const int s_row = tid >> 2, cq = tid & 3;
  const float mu = stat[s_row * 2], rstd = stat[s_row * 2 + 1];
  for (int hf = 0; hf < 2; ++hf) {
    {
      u32x4 w[8];
#pragma unroll
      for (int o = 0; o < 8; ++o) w[o] = *(const u32x4*)(P + (tok0 + s_row) * NP + C_VB + hf * 256 + cq * 64 + o * 8);
#pragma unroll
      for (int o = 0; o < 8; ++o) {
        const int c0 = hf * 256 + cq * 64 + o * 8;
        const f32x4 g0 = *(const LAS f32x4*)(lng + c0), g1 = *(const LAS f32x4*)(lng + c0 + 4), b0 = *(const LAS f32x4*)(lnb + c0), b1 = *(const LAS f32x4*)(lnb + c0 + 4);
        u32x4 r;
        r.x = pk_bf16((fgelu(bflo(w[o].x)) - mu) * rstd * g0[0] + b0[0], (fgelu(bfhi(w[o].x)) - mu) * rstd * g0[1] + b0[1]);
        r.y = pk_bf16((fgelu(bflo(w[o].y)) - mu) * rstd * g0[2] + b0[2], (fgelu(bfhi(w[o].y)) - mu) * rstd * g0[3] + b0[3]);
        r.z = pk_bf16((fgelu(bflo(w[o].z)) - mu) * rstd * g1[0] + b1[0], (fgelu(bfhi(w[o].z)) - mu) * rstd * g1[1] + b1[1]);
        r.w = pk_bf16((fgelu(bflo(w[o].w)) - mu) * rstd * g1[2] + b1[2], (fgelu(bfhi(w[o].w)) - mu) * rstd * g1[3] + b1[3]);
        *(LAS u32x4*)(vn + s_row * SG_LD + cq * 64 + o * 8) = r;
      }
    }
    __syncthreads();
    const int t = wid * 16 + fr;
#pragma unroll
    for (int gg = 0; gg < 2; ++gg) {
      const int g = hf * 2 + gg;
      const float* wrow = p.w_sp + (((size_t)l * 4 + g) * 128 + t) * 128;
      bf16x8 bfrag[4];
      f32x4 wa[4], wb[4];
#pragma unroll
      for (int kk = 0; kk < 4; ++kk) { wa[kk] = *(const f32x4*)(wrow + kk * 32 + fq * 4); wb[kk] = *(const f32x4*)(wrow + kk * 32 + 16 + fq * 4); }
      const float bias = p.b_sp[((size_t)l * 4 + g) * 128 + t];
      u32x2 uu[8], zz[8];
#pragma unroll
      for (int ct = 0; ct < 8; ++ct) { const size_t off = (tok0 + t) * NP + g * 128 + ct * 16 + fq * 4; uu[ct] = *(const u32x2*)(P + off + C_UB); zz[ct] = *(const u32x2*)(P + off + C_ZB); }
      asm volatile("" ::: "memory");
#pragma unroll
      for (int kk = 0; kk < 4; ++kk) { u32x4 w; w.x = pk_bf16(wa[kk][0], wa[kk][1]); w.y = pk_bf16(wa[kk][2], wa[kk][3]); w.z = pk_bf16(wb[kk][0], wb[kk][1]); w.w = pk_bf16(wb[kk][2], wb[kk][3]); bfrag[kk] = __builtin_bit_cast(bf16x8, w); }
#pragma unroll
      for (int ct = 0; ct < 8; ++ct) {
        f32x4 acc = {0.f, 0.f, 0.f, 0.f};
#pragma unroll
        for (int kk = 0; kk < 4; ++kk) {
          const LAS bf16_t* base = vn + (kk * 32 + fq * 4 + (fr >> 2)) * SG_LD + gg * 128 + ct * 16 + (fr & 3) * 4;
          const bf16x8 a = tr_pair(base, base + 16 * SG_LD);
          acc = mfma16(a, bfrag[kk], acc);
        }
        const size_t off = (tok0 + t) * NP + g * 128 + ct * 16 + fq * 4;
        const float o0 = fgelu(bflo(uu[ct].x)) * (acc[0] + bias) * fsilu(bflo(zz[ct].x)), o1 = fgelu(bfhi(uu[ct].x)) * (acc[1] + bias) * fsilu(bfhi(zz[ct].x));
        const float o2 = fgelu(bflo(uu[ct].y)) * (acc[2] + bias) * fsilu(bflo(zz[ct].y)), o3 = fgelu(bfhi(uu[ct].y)) * (acc[3] + bias) * fsilu(bfhi(zz[ct].y));
        u32x2 w; w.x = pk_bf16(o0, o1); w.y = pk_bf16(o2, o3);
        *(u32x2*)(P + off + C_UB) = w;
      }
    }
    __syncthreads();
  }
}

constexpr int AT_KLD = 80;
constexpr int AT_VLD = 80;
DI void rope8(const float (&x1)[8], const float (&x2)[8], float rstd, const float* g1, const float* g2, const float* cs, u32x4& o0, u32x4& o1) {
  const f32x4 c0 = *(const f32x4*)cs, c1 = *(const f32x4*)(cs + 4), s0 = *(const f32x4*)(cs + 32), s1 = *(const f32x4*)(cs + 36);
  const f32x4 ga0 = *(const f32x4*)g1, ga1 = *(const f32x4*)(g1 + 4), gb0 = *(const f32x4*)g2, gb1 = *(const f32x4*)(g2 + 4);
  float y1[8], y2[8];
#pragma unroll
  for (int j = 0; j < 8; ++j) {
    const float c = j < 4 ? c0[j & 3] : c1[j & 3], sn = j < 4 ? s0[j & 3] : s1[j & 3];
    const float a = x1[j] * rstd * (j < 4 ? ga0[j & 3] : ga1[j & 3]), bb = x2[j] * rstd * (j < 4 ? gb0[j & 3] : gb1[j & 3]);
    y1[j] = a * c - bb * sn; y2[j] = bb * c + a * sn;
  }
  o0.x = pk_bf16(y1[0], y1[1]); o0.y = pk_bf16(y1[2], y1[3]); o0.z = pk_bf16(y1[4], y1[5]); o0.w = pk_bf16(y1[6], y1[7]);
  o1.x = pk_bf16(y2[0], y2[1]); o1.y = pk_bf16(y2[2], y2[3]); o1.z = pk_bf16(y2[4], y2[5]); o1.w = pk_bf16(y2[6], y2[7]);
}
DI void attn_item(LAS unsigned char* lds, const Params& p, int l, int item) {
  bf16_t* P = (bf16_t*)(p.ws + WS_PROJ);
  const float* ropec = (const float*)(p.ws + WS_ROPE);
  const int tid = opaque_tid(), wid = __builtin_amdgcn_readfirstlane(tid >> 6), lane = tid & 63, fr = lane & 15, fq = lane >> 4;
  const int blk = item & 63, kvh = (item >> 6) & 1, b = item >> 7;
  const size_t tokb = (size_t)b * SEQ;
  LAS bf16_t* Ks = (LAS bf16_t*)lds;
  LAS bf16_t* Vs = (LAS bf16_t*)(lds + 384 * AT_KLD * 2);
  const float* qg = p.qg + l * 64; const float* kg = p.kg + l * 64;
  __syncthreads();
  {
    u32x4 w[6];
#pragma unroll
    for (int it = 0; it < 6; ++it) { const int task = it * 512 + tid; const int kk = task >> 3, o8 = task & 7; const int pos = blk * 128 - 128 + kk;
      const int pc = pos < 0 ? 0 : (pos >= SEQ ? SEQ - 1 : pos);
      w[it] = *(const u32x4*)(P + (tokb + pc) * NP + C_VC + kvh * 64 + o8 * 8); }
#pragma unroll
    for (int it = 0; it < 6; ++it) { const int task = it * 512 + tid; const int kk = task >> 3, o8 = task & 7; *(LAS u32x4*)(Vs + kk * AT_VLD + o8 * 8) = w[it]; }
  }
  {
    u32x4 w0[3], w1[3];
#pragma unroll
    for (int it = 0; it < 3; ++it) { const int task = it * 512 + tid; const int kk = task >> 2, o = task & 3; const int pos = blk * 128 - 128 + kk;
      const int pc = pos < 0 ? 0 : (pos >= SEQ ? SEQ - 1 : pos);
      const bf16_t* src = P + (tokb + pc) * NP + C_KC + kvh * 64 + o * 8; w0[it] = *(const u32x4*)src; w1[it] = *(const u32x4*)(src + 32); }
#pragma unroll
    for (int it = 0; it < 3; ++it) { const int task = it * 512 + tid; const int kk = task >> 2, o = task & 3; const int pos = blk * 128 - 128 + kk;
      const float x1[8] = {bflo(w0[it].x), bfhi(w0[it].x), bflo(w0[it].y), bfhi(w0[it].y), bflo(w0[it].z), bfhi(w0[it].z), bflo(w0[it].w), bfhi(w0[it].w)};
      const float x2[8] = {bflo(w1[it].x), bfhi(w1[it].x), bflo(w1[it].y), bfhi(w1[it].y), bflo(w1[it].z), bfhi(w1[it].z), bflo(w1[it].w), bfhi(w1[it].w)};
      float ss = 0.f;
#pragma unroll
      for (int j = 0; j < 8; ++j) ss += x1[j] * x1[j] + x2[j] * x2[j];
      ss += __shfl_xor(ss, 1); ss += __shfl_xor(ss, 2);
      const float rstd = rsqrtf(ss * (1.0f / 64.0f) + EPS);
      const int pc = pos < 0 ? 0 : (pos >= SEQ ? SEQ - 1 : pos);
      u32x4 o0, o1; rope8(x1, x2, rstd, kg + o * 8, kg + 32 + o * 8, ropec + (size_t)pc * 64 + o * 8, o0, o1);
      *(LAS u32x4*)(Ks + kk * AT_KLD + o * 8) = o0; *(LAS u32x4*)(Ks + kk * AT_KLD + 32 + o * 8) = o1; }
  }
  float gq = fabsf(qg[lane]), gk = fabsf(kg[lane]);
#pragma unroll
  for (int o = 32; o >= 1; o >>= 1) { gq = fmaxf(gq, __shfl_xor(gq, o)); gk = fmaxf(gk, __shfl_xor(gk, o)); }
  const int hq = kvh * 4 + (wid & 3), half = wid >> 2;
  const float sinkv = p.sink[l * 8 + hq];
  const float mshift = fmaxf(8.0f * gq * gk, sinkv) * 1.4426950408889634f;
  bf16x8 qf[4][2];
  {
    u32x4 w0[4], w1[4];
#pragma unroll
    for (int qt = 0; qt < 4; ++qt) { const int pos = blk * 128 + half * 64 + qt * 16 + fr; const bf16_t* src = P + (tokb + pos) * NP + C_QC + hq * 64 + fq * 8; w0[qt] = *(const u32x4*)src; w1[qt] = *(const u32x4*)(src + 32); }
#pragma unroll
    for (int qt = 0; qt < 4; ++qt) {
      const int pos = blk * 128 + half * 64 + qt * 16 + fr;
      const float x1[8] = {bflo(w0[qt].x), bfhi(w0[qt].x), bflo(w0[qt].y), bfhi(w0[qt].y), bflo(w0[qt].z), bfhi(w0[qt].z), bflo(w0[qt].w), bfhi(w0[qt].w)};
      const float x2[8] = {bflo(w1[qt].x), bfhi(w1[qt].x), bflo(w1[qt].y), bfhi(w1[qt].y), bflo(w1[qt].z), bfhi(w1[qt].z), bflo(w1[qt].w), bfhi(w1[qt].w)};
      float ss = 0.f;
#pragma unroll
      for (int j = 0; j < 8; ++j) ss += x1[j] * x1[j] + x2[j] * x2[j];
      ss += __shfl_xor(ss, 16); ss += __shfl_xor(ss, 32);
      const float rstd = rsqrtf(ss * (1.0f / 64.0f) + EPS) * (0.125f * 1.4426950408889634f);
      u32x4 o0, o1; rope8(x1, x2, rstd, qg + fq * 8, qg + 32 + fq * 8, ropec + (size_t)pos * 64 + fq * 8, o0, o1);
      qf[qt][0] = __builtin_bit_cast(bf16x8, o0); qf[qt][1] = __builtin_bit_cast(bf16x8, o1);
    }
  }
  __syncthreads();
  f32x4 oacc[4][4];
  float lsum[4] = {0.f, 0.f, 0.f, 0.f};
#pragma unroll
  for (int a = 0; a < 4; ++a)
#pragma unroll
    for (int c = 0; c < 4; ++c) oacc[a][c] = (f32x4){0.f, 0.f, 0.f, 0.f};
  const int qs = half * 64;
  for (int kp = 0; kp < 12; ++kp) {
    const int k0 = kp * 32 - 128;
    if (k0 + 31 < qs - 128 || k0 > qs + 63 + 128) continue;
    const int kabs0 = blk * 128 + k0;
    if (kabs0 + 31 < 0 || kabs0 >= SEQ) continue;
    bf16x8 kf[2][2];
#pragma unroll
    for (int kt = 0; kt < 2; ++kt)
#pragma unroll
      for (int hh = 0; hh < 2; ++hh) kf[kt][hh] = *(const LAS bf16x8*)(Ks + (kp * 32 + kt * 16 + fr) * AT_KLD + hh * 32 + fq * 8);
    bf16x8 vf[4];
#pragma unroll
    for (int dt = 0; dt < 4; ++dt) { const LAS bf16_t* base = Vs + (kp * 32 + fq * 4 + (fr >> 2)) * AT_VLD + dt * 16 + (fr & 3) * 4; vf[dt] = tr_pair(base, base + 16 * AT_VLD); }
#pragma unroll
    for (int qt = 0; qt < 4; ++qt) {
      const int q0 = qs + qt * 16;
      const bool interior = (k0 + 31 - q0 <= 128) && (q0 + 15 - k0 <= 128) && (kabs0 >= 0) && (kabs0 + 31 < SEQ);
      const int qrel = q0 + fr;
      float pv[8];
#pragma unroll
      for (int kt = 0; kt < 2; ++kt) {
        f32x4 sc = {0.f, 0.f, 0.f, 0.f};
        sc = mfma16(kf[kt][0], qf[qt][0], sc); sc = mfma16(kf[kt][1], qf[qt][1], sc);
        if (interior) {
#pragma unroll
          for (int j = 0; j < 4; ++j) { const float e = __builtin_amdgcn_exp2f(sc[j] - mshift); pv[kt * 4 + j] = e; lsum[qt] += e; }
        } else {
#pragma unroll
          for (int j = 0; j < 4; ++j) {
            const int krel = k0 + kt * 16 + fq * 4 + j; const int kab = blk * 128 + krel; const int d = krel - qrel;
            const bool ok = (d <= 128) && (d >= -128) && (kab >= 0) && (kab < SEQ);
            const float e = ok ? __builtin_amdgcn_exp2f(sc[j] - mshift) : 0.f;
            pv[kt * 4 + j] = e; lsum[qt] += e;
          }
        }
      }
      u32x4 pw; pw.x = pk_bf16(pv[0], pv[1]); pw.y = pk_bf16(pv[2], pv[3]); pw.z = pk_bf16(pv[4], pv[5]); pw.w = pk_bf16(pv[6], pv[7]);
      const bf16x8 pb = __builtin_bit_cast(bf16x8, pw);
#pragma unroll
      for (int dt = 0; dt < 4; ++dt) oacc[dt][qt] = mfma16(vf[dt], pb, oacc[dt][qt]);
    }
  }
  const float esink = __builtin_amdgcn_exp2f(sinkv * 1.4426950408889634f - mshift);
  u32x2 zz[4][4];
#pragma unroll
  for (int qt = 0; qt < 4; ++qt)
#pragma unroll
    for (int dt = 0; dt < 4; ++dt) { const int pos = blk * 128 + half * 64 + qt * 16 + fr; zz[qt][dt] = *(const u32x2*)(P + (tokb + pos) * NP + hq * 64 + dt * 16 + fq * 4 + C_ZC); }
#pragma unroll
  for (int qt = 0; qt < 4; ++qt) {
    float ls = lsum[qt]; ls += __shfl_xor(ls, 16); ls += __shfl_xor(ls, 32);
    const float inv = 1.0f / (ls + esink);
    const int pos = blk * 128 + half * 64 + qt * 16 + fr;
#pragma unroll
    for (int dt = 0; dt < 4; ++dt) {
      const size_t off = (tokb + pos) * NP + hq * 64 + dt * 16 + fq * 4;
      const u32x2 z = zz[qt][dt];
      u32x2 w; w.x = pk_bf16(oacc[dt][qt][0] * inv * fsilu(bflo(z.x)), oacc[dt][qt][1] * inv * fsilu(bfhi(z.x))); w.y = pk_bf16(oacc[dt][qt][2] * inv * fsilu(bflo(z.y)), oacc[dt][qt][3] * inv * fsilu(bfhi(z.y)));
      *(u32x2*)(P + off + C_QC) = w;
    }
  }
}

constexpr int SCR = 512, NSC = SEQ / SCR, NSUB = SCR / 64;
constexpr int H_QLD = 144, H_TLD = 80;
constexpr int H_QS = 0, H_KS = H_QS + 64 * H_QLD * 2, H_KT = H_KS + 64 * H_QLD * 2, H_VT = H_KT + 128 * H_TLD * 2, H_ST = H_VT + 128 * H_TLD * 2,
              H_SEG = H_ST + 128 * H_QLD * 2, H_SSQ = H_SEG + 2 * 4 * 128 * 4, H_GN = H_SSQ + 2 * 64 * 4, H_END = H_GN + 128 * 4;
static_assert(H_END <= LDS_BYTES, "hgrn lds");

template <bool OUT>
DI void hgrn_super(LAS unsigned char* lds, const Params& p, int l, int b, int h, int nn, int dir, f32x4 (&S)[8], float& btot) {
  bf16_t* P = (bf16_t*)(p.ws + WS_PROJ);
  const int tid = opaque_tid(), wid = __builtin_amdgcn_readfirstlane(tid >> 6), lane = tid & 63, fr = lane & 15, fq = lane >> 4;
  const int d = tid & 127, seg = tid >> 7;
  LAS bf16_t* Qs = (LAS bf16_t*)(lds + H_QS); LAS bf16_t* Ks = (LAS bf16_t*)(lds + H_KS); LAS bf16_t* KT = (LAS bf16_t*)(lds + H_KT);
  LAS bf16_t* Vt = (LAS bf16_t*)(lds + H_VT); LAS bf16_t* St = (LAS bf16_t*)(lds + H_ST); LAS float* segtot2 = (LAS float*)(lds + H_SEG); LAS float* ssqb = (LAS float*)(lds + H_SSQ);
  const size_t tokbase = (size_t)b * SEQ + (size_t)nn * SCR;
  const int lfcol = (dir ? C_LFB : C_LFF) + h * 128;
  LAS float* gnl = (LAS float*)(lds + H_GN);
  if (OUT && dir == 1 && tid < 128) gnl[tid] = p.hg_gain[(size_t)l * 512 + h * 128 + tid];
  unsigned short lfr[16], vv[16], qr[16];
#define H_LOADS(CC) do { _Pragma("unroll") for (int i = 0; i < 16; ++i) { const int r_ = (CC) * 64 + seg * 16 + i; const size_t tok_ = tokbase + (dir ? (SCR - 1) - r_ : r_); \
      const bf16_t* rowp_ = P + tok_ * NP; lfr[i] = rowp_[lfcol + d]; vv[i] = rowp_[C_IA + h * 128 + d]; if (OUT) qr[i] = rowp_[C_QA + h * 128 + d]; } } while (0)
  H_LOADS(0);
  for (int cc = 0; cc < NSUB; ++cc) {
    float lfv[16], loc[16], qv[16];
    float run = 0.f;
#pragma unroll
    for (int i = 0; i < 16; ++i) { lfv[i] = h2f(lfr[i]); if (OUT) qv[i] = bf2f(qr[i]); run += lfv[i]; loc[i] = run; }
    LAS float* segtot = segtot2 + (cc & 1) * 512;
    segtot[seg * 128 + d] = run;
    lds_barrier();
    {
      const float s0 = segtot[d], s1 = segtot[128 + d], s2 = segtot[256 + d], s3 = segtot[384 + d];
      const float bmid = s0 + s1, bend = bmid + s2 + s3;
      const float off = (seg > 0 ? s0 : 0.f) + (seg > 1 ? s1 : 0.f) + (seg > 2 ? s2 : 0.f);
      btot += bend;
      const float dof = off - bmid;
      unsigned ktw[8];
#pragma unroll
      for (int i = 0; i < 16; i += 2) {
        const float d0 = dof + loc[i], d1 = dof + loc[i + 1];
        const float k0 = 1.0f - __builtin_amdgcn_exp2f(lfv[i]), k1 = 1.0f - __builtin_amdgcn_exp2f(lfv[i + 1]);
        const unsigned kw = pk_bf16(k0 * __builtin_amdgcn_exp2f(fminf(-d0, 115.f)), k1 * __builtin_amdgcn_exp2f(fminf(-d1, 115.f)));
        ktw[i >> 1] = kw;
        if (OUT) { const int r = seg * 16 + i;
          const unsigned qw = pk_bf16(qv[i] * __builtin_amdgcn_exp2f(fminf(d0, 115.f)), qv[i + 1] * __builtin_amdgcn_exp2f(fminf(d1, 115.f)));
          Ks[r * H_QLD + d] = (bf16_t)(kw & 0xffffu); Ks[(r + 1) * H_QLD + d] = (bf16_t)(kw >> 16);
          Qs[r * H_QLD + d] = (bf16_t)(qw & 0xffffu); Qs[(r + 1) * H_QLD + d] = (bf16_t)(qw >> 16); }
      }
      u32x4 w0, w1;
      w0.x = ktw[0]; w0.y = ktw[1]; w0.z = ktw[2]; w0.w = ktw[3]; w1.x = ktw[4]; w1.y = ktw[5]; w1.z = ktw[6]; w1.w = ktw[7];
      *(LAS u32x4*)(KT + d * H_TLD + seg * 16) = w0; *(LAS u32x4*)(KT + d * H_TLD + seg * 16 + 8) = w1;
      w0.x = vv[0] | ((unsigned)vv[1] << 16); w0.y = vv[2] | ((unsigned)vv[3] << 16); w0.z = vv[4] | ((unsigned)vv[5] << 16); w0.w = vv[6] | ((unsigned)vv[7] << 16);
      w1.x = vv[8] | ((unsigned)vv[9] << 16); w1.y = vv[10] | ((unsigned)vv[11] << 16); w1.z = vv[12] | ((unsigned)vv[13] << 16); w1.w = vv[14] | ((unsigned)vv[15] << 16);
      *(LAS u32x4*)(Vt + d * H_TLD + seg * 16) = w0; *(LAS u32x4*)(Vt + d * H_TLD + seg * 16 + 8) = w1;
    }
    if (cc < NSUB - 1) H_LOADS(cc + 1);
    float e1[4], e2[4], em[4];
#pragma unroll
    for (int j = 0; j < 4; ++j) { const int dk = wid * 16 + fq * 4 + j; const float s0 = segtot[dk], s1 = segtot[128 + dk], s2 = segtot[256 + dk], s3 = segtot[384 + dk];
      em[j] = __builtin_amdgcn_exp2f(s0 + s1); e2[j] = __builtin_amdgcn_exp2f(s2 + s3); e1[j] = __builtin_amdgcn_exp2f(s0 + s1 + s2 + s3); }
    if (OUT) {
#pragma unroll
      for (int dvt = 0; dvt < 8; ++dvt) { u32x2 w; w.x = pk_bf16(S[dvt][0] * em[0], S[dvt][1] * em[1]); w.y = pk_bf16(S[dvt][2] * em[2], S[dvt][3] * em[3]);
        *(LAS u32x2*)(St + (dvt * 16 + fr) * H_QLD + wid * 16 + fq * 4) = w; }
    }
    lds_barrier();
    f32x4 oo[4];
    const int tt = wid & 3, dh = wid >> 2;
    u32x2 zzv[4]; unsigned long long ofv[4];
    if (OUT && dir == 1) {
      const int r = cc * 64 + tt * 16 + fr; const size_t tok = tokbase + (size_t)((SCR - 1) - r);
#pragma unroll
      for (int i = 0; i < 4; ++i) { const int col = h * 128 + dh * 64 + i * 16 + fq * 4;
        zzv[i] = *(const u32x2*)(P + tok * NP + C_ZA + col);
        ofv[i] = __hip_atomic_load((const unsigned long long*)(P + tok * NP + C_LFF + col), __ATOMIC_RELAXED, __HIP_MEMORY_SCOPE_AGENT); }
    }
    if (OUT) {
      bf16x8 qf[4];
#pragma unroll
      for (int kk = 0; kk < 4; ++kk) qf[kk] = *(const LAS bf16x8*)(Qs + (tt * 16 + fr) * H_QLD + kk * 32 + fq * 8);
      f32x4 pt[4];
#pragma unroll
      for (int st = 0; st < 4; ++st) {
        pt[st] = (f32x4){0.f, 0.f, 0.f, 0.f};
        if (st <= tt) {
          f32x4 a = {0.f, 0.f, 0.f, 0.f};
#pragma unroll
          for (int kk = 0; kk < 4; ++kk) { const bf16x8 kf = *(const LAS bf16x8*)(Ks + (st * 16 + fr) * H_QLD + kk * 32 + fq * 8); a = mfma16(kf, qf[kk], a); }
#pragma unroll
          for (int j = 0; j < 4; ++j) pt[st][j] = (st * 16 + fq * 4 + j <= tt * 16 + fr) ? a[j] : 0.f;
        }
      }
      bf16x8 pb[2];
#pragma unroll
      for (int pp = 0; pp < 2; ++pp) { u32x4 w; w.x = pk_bf16(pt[2 * pp][0], pt[2 * pp][1]); w.y = pk_bf16(pt[2 * pp][2], pt[2 * pp][3]); w.z = pk_bf16(pt[2 * pp + 1][0], pt[2 * pp + 1][1]); w.w = pk_bf16(pt[2 * pp + 1][2], pt[2 * pp + 1][3]);
        pb[pp] = __builtin_bit_cast(bf16x8, w); }
#pragma unroll
      for (int i = 0; i < 4; ++i) {
        const int dvt = dh * 4 + i; f32x4 a = {0.f, 0.f, 0.f, 0.f};
#pragma unroll
        for (int pp = 0; pp < 2; ++pp) if (2 * pp <= tt) {
          const bf16x4 v0 = *(const LAS bf16x4*)(Vt + (dvt * 16 + fr) * H_TLD + pp * 32 + fq * 4), v1 = *(const LAS bf16x4*)(Vt + (dvt * 16 + fr) * H_TLD + pp * 32 + 16 + fq * 4);
          const bf16x8 vf = {v0[0], v0[1], v0[2], v0[3], v1[0], v1[1], v1[2], v1[3]};
          a = mfma16(vf, pb[pp], a); }
#pragma unroll
        for (int kk = 0; kk < 4; ++kk) { const bf16x8 sf = *(const LAS bf16x8*)(St + (dvt * 16 + fr) * H_QLD + kk * 32 + fq * 8); a = mfma16(sf, qf[kk], a); }
        oo[i] = a;
      }
      const int r = cc * 64 + tt * 16 + fr; const size_t tok = tokbase + (dir ? (SCR - 1) - r : r);
      if (dir == 0) {
#pragma unroll
        for (int i = 0; i < 4; ++i) { u32x2 w; w.x = pk_bf16(oo[i][0], oo[i][1]); w.y = pk_bf16(oo[i][2], oo[i][3]);
          *(u32x2*)(P + tok * NP + C_LFF + h * 128 + dh * 64 + i * 16 + fq * 4) = w; }
      } else {
        float ss = 0.f;
#pragma unroll
        for (int i = 0; i < 4; ++i) {
          const unsigned long long ww = ofv[i];
          const unsigned lo = (unsigned)ww, hi = (unsigned)(ww >> 32);
          oo[i][0] += bflo(lo); oo[i][1] += bfhi(lo); oo[i][2] += bflo(hi); oo[i][3] += bfhi(hi);
          ss += (oo[i][0] * oo[i][0] + oo[i][1] * oo[i][1]) + (oo[i][2] * oo[i][2] + oo[i][3] * oo[i][3]);
        }
        ss += __shfl_xor(ss, 16); ss += __shfl_xor(ss, 32);
        if (fq == 0) ssqb[dh * 64 + tt * 16 + fr] = ss;
      }
    }
#pragma unroll
    for (int dvt = 0; dvt < 8; ++dvt) {
      f32x4 a = {0.f, 0.f, 0.f, 0.f};
#pragma unroll
      for (int kk = 0; kk < 2; ++kk) { const bf16x8 kf = *(const LAS bf16x8*)(KT + (wid * 16 + fr) * H_TLD + kk * 32 + fq * 8), vf = *(const LAS bf16x8*)(Vt + (dvt * 16 + fr) * H_TLD + kk * 32 + fq * 8);
        a = mfma16(kf, vf, a); }
#pragma unroll
      for (int j = 0; j < 4; ++j) S[dvt][j] = e1[j] * S[dvt][j] + e2[j] * a[j];
    }
    if (OUT && dir == 1) {
      lds_barrier();
      const int r = cc * 64 + tt * 16 + fr; const size_t tok = tokbase + (size_t)((SCR - 1) - r);
      const float tot = ssqb[tt * 16 + fr] + ssqb[64 + tt * 16 + fr];
      const float rs = rsqrtf(tot * (1.0f / 128.0f) + EPS);
#pragma unroll
      for (int i = 0; i < 4; ++i) {
        const int col = h * 128 + dh * 64 + i * 16 + fq * 4;
        const f32x4 gn = *(const LAS f32x4*)(gnl + dh * 64 + i * 16 + fq * 4);
        const u32x2 zz = zzv[i];
        u32x2 w; w.x = pk_bf16(oo[i][0] * rs * gn[0] * fsilu(bflo(zz.x)), oo[i][1] * rs * gn[1] * fsilu(bfhi(zz.x))); w.y = pk_bf16(oo[i][2] * rs * gn[2] * fsilu(bflo(zz.y)), oo[i][3] * rs * gn[3] * fsilu(bfhi(zz.y)));
        *(u32x2*)(P + tok * NP + C_QA + col) = w;
      }
    }
  }
}


#define XB_TMO      128
#define XB_XCNT(j)  (256  + 64 * (j))
#define XB_XSUB(j)  (1280 + 64 * (j))
#define XB_XGEN(j)  (2304 + 64 * (j))
#define XB_TOP      3328
#define XB_TOPGEN   3392
#define XCD_BAR_WORDS 3456
#define XB_SPIN_CAP (1u << 22)
DI unsigned xb_ld(unsigned* p) { return __hip_atomic_load(p, __ATOMIC_RELAXED, __HIP_MEMORY_SCOPE_AGENT); }
DI unsigned xb_add(unsigned* p, unsigned v) { return __hip_atomic_fetch_add(p, v, __ATOMIC_RELAXED, __HIP_MEMORY_SCOPE_AGENT); }
DI unsigned xb_xcc_id() { return (unsigned)__builtin_amdgcn_s_getreg((3 << 11) | 20) & 0xFu; }
#define XB_SPIN(cond, bar) do { unsigned _sp = 0; while (cond) { __builtin_amdgcn_s_sleep(1); \
    if ((++_sp & 255u) == 0u) { if (xb_ld(&(bar)[XB_TMO])) break; if (_sp > XB_SPIN_CAP) { atomicAdd(&(bar)[XB_TMO], 1u); break; } } } } while (0)
struct XcdBarrier { unsigned* bar; unsigned x; volatile LAS unsigned* st; };
DI XcdBarrier xcd_barrier_post(unsigned* bar, volatile LAS unsigned* st) {
  XcdBarrier b; b.bar = bar; b.x = xb_xcc_id(); b.st = st;
  if (threadIdx.x == 0) (void)xb_add(&bar[XB_XCNT(b.x)], 1u);
  return b;
}
DI void xcd_barrier_complete(unsigned* bar, unsigned x, unsigned& nloc, unsigned& nx) {
  const unsigned G = gridDim.x;
  unsigned sum, cnt, mine, sp = 0u;
  for (;;) {
    sum = 0u; cnt = 0u; mine = 0u;
#pragma unroll
    for (unsigned j = 0; j < 16; ++j) { const unsigned c = xb_ld(&bar[XB_XCNT(j)]); sum += c; cnt += (c > 0u) ? 1u : 0u; mine = (j == x) ? c : mine; }
    if (sum == G) break;
    __builtin_amdgcn_s_sleep(1);
    if ((++sp & 255u) == 0u) { if (xb_ld(&bar[XB_TMO])) break; if (sp > XB_SPIN_CAP) { atomicAdd(&bar[XB_TMO], 1u); break; } }
  }
  nloc = mine > 0u ? mine : 1u; nx = cnt > 0u ? cnt : 1u;
}
DI void xcd_barrier(const XcdBarrier& b) {
  asm volatile("s_waitcnt vmcnt(0)" ::: "memory");
  __syncthreads();
  if (threadIdx.x == 0) {
    unsigned* bar = b.bar;
    __builtin_amdgcn_s_waitcnt(0);
    unsigned nloc = b.st[0], nx = b.st[1];
    if (nloc == 0u) { xcd_barrier_complete(bar, b.x, nloc, nx); b.st[0] = nloc; b.st[1] = nx; }
    const unsigned old = xb_add(&bar[XB_XSUB(b.x)], 1u);
    const unsigned gen = old / nloc;
    if (old + 1u == (gen + 1u) * nloc) {
      __builtin_amdgcn_fence(__ATOMIC_RELEASE, "agent");
      asm volatile("s_waitcnt vmcnt(0)" ::: "memory");
      const unsigned og = xb_add(&bar[XB_TOP], 1u);
      const unsigned tg = og / nx;
      if (og + 1u == (tg + 1u) * nx) xb_add(&bar[XB_TOPGEN], 1u);
      else XB_SPIN(xb_ld(&bar[XB_TOPGEN]) == tg, bar);
      __builtin_amdgcn_fence(__ATOMIC_ACQUIRE, "agent");
      xb_add(&bar[XB_XGEN(b.x)], 1u);
      asm volatile("s_waitcnt vmcnt(0)" ::: "memory");
    } else {
      XB_SPIN(xb_ld(&bar[XB_XGEN(b.x)]) == gen, bar);
      __builtin_amdgcn_fence(__ATOMIC_ACQUIRE, "agent");
      asm volatile("s_waitcnt vmcnt(0)" ::: "memory");
    }
  }
  __syncthreads();
}
#ifndef PHM
#define PHM 0xffff
#endif
__global__ void __launch_bounds__(512, 2) fwd_mega(Params p) {
  extern __shared__ __attribute__((aligned(16))) unsigned char lds_raw[];
  LAS unsigned char* lds = (LAS unsigned char*)lds_raw;
  cg::grid_group grid = cg::this_grid();
  if (threadIdx.x < 4) ((LAS unsigned*)(lds + LDS_XB))[threadIdx.x] = 0u;
  __syncthreads();
  const XcdBarrier xbar = xcd_barrier_post((unsigned*)(p.ws + WS_BAR), (volatile LAS unsigned*)(lds + LDS_XB));
  const int G = gridDim.x, bid = blockIdx.x;
  const long gthreads = (long)G * 512;
#define LANEVARS const int tid = opaque_tid(); const int wid = __builtin_amdgcn_readfirstlane(tid >> 6), lane = tid & 63; const long gtid = (long)bid * 512 + tid; (void)wid; (void)lane; (void)gtid
  unsigned char* ws = p.ws;
  bf16_t* P = (bf16_t*)(ws + WS_PROJ); bf16_t* XB = (bf16_t*)(ws + WS_XB);
  bf16_t* WIN = (bf16_t*)(ws + WS_WIN); bf16_t* WG = (bf16_t*)(ws + WS_WG); bf16_t* WBR = (bf16_t*)(ws + WS_WBR); bf16_t* WOUT = (bf16_t*)(ws + WS_WOUT);
  float* ST = (float*)(ws + WS_ST); float* DD = (float*)(ws + WS_DD); float* SSQ = (float*)(ws + WS_SSQ);
  float* ROPE = (float*)(ws + WS_ROPE); float* LB = (float*)(ws + WS_LB);

  {
    LANEVARS;
    for (int r = (bid * 8 + wid) * 2; r < T_TOK; r += G * 16) {
      f32x4 v[2][4];
#pragma unroll
      for (int rr = 0; rr < 2; ++rr)
#pragma unroll
        for (int i = 0; i < 4; ++i) v[rr][i] = *(const f32x4*)(p.x + (size_t)(r + rr) * DM + i * 256 + lane * 4);
#pragma unroll
      for (int rr = 0; rr < 2; ++rr) {
        float ss = 0.f;
#pragma unroll
        for (int i = 0; i < 4; ++i) {
          u32x2 w; w.x = pk_bf16(v[rr][i][0], v[rr][i][1]); w.y = pk_bf16(v[rr][i][2], v[rr][i][3]);
          *(u32x2*)(XB + (size_t)(r + rr) * DM + i * 256 + lane * 4) = w;
          ss += (v[rr][i][0] * v[rr][i][0] + v[rr][i][1] * v[rr][i][1]) + (v[rr][i][2] * v[rr][i][2] + v[rr][i][3] * v[rr][i][3]);
        }
#pragma unroll
        for (int o = 32; o >= 1; o >>= 1) ss += __shfl_xor(ss, o);
        if (lane < 16) SSQ[(size_t)(r + rr) * 16 + lane] = lane == 0 ? ss : 0.f;
      }
    }
    for (long i = gtid; i < (long)SEQ * 32; i += gthreads) {
      const int pos = (int)(i >> 5), j = (int)(i & 31);
      const float invf = powf(10000.0f, -(float)j / 32.0f);
      const float ang = (float)pos * invf;
      double rev = (double)ang * 0.15915494309189535; rev -= floor(rev);
      ROPE[(size_t)pos * 64 + j] = __builtin_amdgcn_cosf((float)rev); ROPE[(size_t)pos * 64 + 32 + j] = __builtin_amdgcn_sinf((float)rev);
    }
    for (long i = gtid; i < 1024; i += gthreads) {
      const float a0 = p.lb_logits[i], a1 = p.lb_logits[1024 + i], a2 = p.lb_logits[2048 + i], a3 = p.lb_logits[3072 + i];
      const float mx = fmaxf(fmaxf(a0, a1), fmaxf(a2, a3));
      const float e0 = expf(a0 - mx), e1 = expf(a1 - mx), e2 = expf(a2 - mx), e3 = expf(a3 - mx); const float inv = 1.0f / (e0 + e1 + e2 + e3);
      LB[i] = 0.f; LB[1024 + i] = e1 * inv; LB[2048 + i] = (e1 + e2) * inv; LB[3072 + i] = (e1 + e2 + e3) * inv;
    }
    convert_w(p.w_in, NIN, DM, WIN, NP, 1, 0, p.norm_gain, gtid, gthreads);
  }
  if (p.use_cg_sync) grid.sync(); else xcd_barrier(xbar);

  for (int l = 0; l < DEPTH; ++l) {
    if (2 * bid >= G) { LANEVARS;
    const long ct = (long)(bid - (G + 1) / 2) * 512 + tid, cth = (long)(G - (G + 1) / 2) * 512;
    convert_w(p.w_in + (size_t)l * DM * NIN, NIN, DM, WG, 3072, 0, NP, p.norm_gain + l * DM, ct, cth);
    convert_w(p.wba + (size_t)l * 512 * DM, DM, 512, WBR, 1024, 0, 0, nullptr, ct, cth);
    convert_w(p.wbb + (size_t)l * 512 * DM, DM, 512, WBR + 1024 * 512, 1024, 0, 0, nullptr, ct, cth);
    convert_w(p.wbc + (size_t)l * 512 * DM, DM, 512, WBR + 2 * 1024 * 512, 1024, 0, 0, nullptr, ct, cth);
    convert_w(p.w_out + (size_t)l * DM * DM, DM, DM, WOUT, 1024, 0, 0, nullptr, ct, cth); }
    if (PHM & 1) {
      GenPlain gen{(const char*)XB, (const char*)WIN, DM * 2, DM * 2, 16, 128, NP / 256, G, bid};
      EpiProj epi{P, SSQ, LB + l * 1024};
      gemm_phase<1>(lds, gen, epi, SSQ);
    }
    xcd_barrier(xbar);
    if (l + 1 < DEPTH) { LANEVARS; convert_w(p.w_in + (size_t)(l + 1) * DM * NIN, NIN, DM, WIN, NP, 1, 0, p.norm_gain + (l + 1) * DM, gtid, gthreads); }
    if (PHM & 2) for (int item = bid; item < 256; item += G) sgu_item(lds, p, l, item);
    if (PHM & 4) for (int item = bid; item < 512; item += G) attn_item(lds, p, l, item);
    if (PHM & 8) for (int item = bid; item < 32 * NSC; item += G) {
      LANEVARS;
      const int seq = item / NSC, n = item % NSC, dir = seq & 1, bh = seq >> 1, b = bh >> 2, h = bh & 3; const int nn = dir ? NSC - 1 - n : n;
      f32x4 S[8];
#pragma unroll
      for (int i = 0; i < 8; ++i) S[i] = (f32x4){0.f, 0.f, 0.f, 0.f};
      float btot = 0.f;
      hgrn_super<false>(lds, p, l, b, h, nn, dir, S, btot);
      float* dst = ST + ((size_t)seq * NSC + n) * 16384;
      const int fr = lane & 15, fq = lane >> 4;
#pragma unroll
      for (int dvt = 0; dvt < 8; ++dvt)
#pragma unroll
        for (int j = 0; j < 4; ++j) dst[(wid * 16 + fq * 4 + j) * 128 + dvt * 16 + fr] = S[dvt][j];
      if (tid < 128) DD[((size_t)seq * NSC + n) * 128 + tid] = __builtin_amdgcn_exp2f(btot);
    }
    xcd_barrier(xbar);
    { LANEVARS;
    for (long e = gtid; e < 32L * 4096; e += gthreads) {
      const int seq = (int)(e >> 12), q4 = (int)(e & 4095); const int dk = q4 >> 5;
      float* base = ST + (size_t)seq * NSC * 16384 + (size_t)q4 * 4; const float* dbase = DD + (size_t)seq * NSC * 128 + dk;
      f32x4 carry = {0.f, 0.f, 0.f, 0.f};
      for (int nb = 0; nb < NSC; nb += 16) {
        f32x4 u[16]; float dc[16];
#pragma unroll
        for (int i = 0; i < 16; ++i) { u[i] = *(const f32x4*)(base + (size_t)(nb + i) * 16384); dc[i] = dbase[(nb + i) * 128]; }
#pragma unroll
        for (int i = 0; i < 16; ++i) { *(f32x4*)(base + (size_t)(nb + i) * 16384) = carry; carry = carry * dc[i] + u[i]; }
      }
    } }
    xcd_barrier(xbar);
    if (PHM & 16) for (int item = bid; item < 16 * NSC; item += G) {
      LANEVARS;
      const int nn = item % NSC, bh = item / NSC, b = bh >> 2, h = bh & 3;
      const int fr = lane & 15, fq = lane >> 4;
      for (int dir = 0; dir < 2; ++dir) {
        const int seq = bh * 2 + dir, n = dir ? NSC - 1 - nn : nn;
        const float* src = ST + ((size_t)seq * NSC + n) * 16384;
        f32x4 S[8];
#pragma unroll
        for (int dvt = 0; dvt < 8; ++dvt)
#pragma unroll
          for (int j = 0; j < 4; ++j) S[dvt][j] = src[(wid * 16 + fq * 4 + j) * 128 + dvt * 16 + fr];
        float btot = 0.f;
        hgrn_super<true>(lds, p, l, b, h, nn, dir, S, btot);
      }
    }
    xcd_barrier(xbar);
    if (PHM & 32) {
      GenMerge gen{(const char*)XB, (const char*)P, (const char*)WG, (const char*)WBR, G, bid};
      EpiMerge epi{P, SSQ, ws + WS_ST + (size_t)bid * 262144};
      gemm_phase<2>(lds, gen, epi, SSQ);
    }
    xcd_barrier(xbar);
    if (PHM & 64) {
      GenPlain gen{(const char*)(P + C_MERGED), (const char*)WOUT, NP * 2, DM * 2, 16, 128, 4, G, bid};
      EpiOut epi{p.x, p.out, XB, SSQ, l == 0 ? 1 : 0, l == DEPTH - 1 ? 1 : 0};
      gemm_phase<0>(lds, gen, epi, SSQ);
    }
    if (l + 1 < DEPTH) xcd_barrier(xbar);
  }
}

extern "C" void kernel_launch(void* const* d_in, const int* in_sizes, int n_in, void* d_out, int out_size,
                              void* d_ws, size_t ws_size, hipStream_t stream) {
  static int grid_blocks = 0;
  if (!grid_blocks) {
    int dev = 0, cus = 0, per_cu = 0;
    (void)hipGetDevice(&dev);
    (void)hipDeviceGetAttribute(&cus, hipDeviceAttributeMultiprocessorCount, dev);
    (void)hipFuncSetAttribute((const void*)fwd_mega, hipFuncAttributeMaxDynamicSharedMemorySize, LDS_BYTES);
    (void)hipOccupancyMaxActiveBlocksPerMultiprocessor(&per_cu, (const void*)fwd_mega, 512, LDS_BYTES);
    (void)hipGetLastError();
    grid_blocks = cus > 0 ? cus : 256;
    if (ws_size < WS_END) { fprintf(stderr, "workspace too small: %zu < %zu\n", ws_size, (size_t)WS_END); grid_blocks = -1; }
  }
  if (grid_blocks < 0) return;
  Params p{};
  p.x = (const float*)d_in[0]; p.w_in = (const float*)d_in[1]; p.norm_gain = (const float*)d_in[2]; p.lb_logits = (const float*)d_in[3];
  p.hg_gain = (const float*)d_in[4]; p.sg_g = (const float*)d_in[5]; p.sg_b = (const float*)d_in[6]; p.w_sp = (const float*)d_in[7];
  p.b_sp = (const float*)d_in[8]; p.qg = (const float*)d_in[9]; p.kg = (const float*)d_in[10]; p.sink = (const float*)d_in[11];
  p.wba = (const float*)d_in[12]; p.wbb = (const float*)d_in[13]; p.wbc = (const float*)d_in[14]; p.w_out = (const float*)d_in[15];
  p.out = (float*)d_out; p.ws = (unsigned char*)d_ws;
  (void)hipMemsetAsync((unsigned char*)d_ws + WS_BAR, 0, 3456 * 4, stream);
  void* args[] = {&p};
  hipError_t e = hipLaunchCooperativeKernel((const void*)fwd_mega, dim3(grid_blocks), dim3(512), args, LDS_BYTES, stream);
  if (e != hipSuccess) fprintf(stderr, "cooperative launch failed: %s (grid %d)\n", hipGetErrorString(e), grid_blocks);
}
```

```cpp
#include <hip/hip_runtime.h>
#include <hip/hip_cooperative_groups.h>
#include <cstdio>
namespace cg = cooperative_groups;

#define LAS __attribute__((address_space(3)))
#define DI __device__ __forceinline__
typedef unsigned short bf16_t;
typedef short bf16x8 __attribute__((ext_vector_type(8)));
typedef short bf16x4 __attribute__((ext_vector_type(4)));
typedef float f32x4 __attribute__((ext_vector_type(4)));
typedef float f32x2 __attribute__((ext_vector_type(2)));
typedef unsigned u32x4 __attribute__((ext_vector_type(4)));
typedef unsigned u32x2 __attribute__((ext_vector_type(2)));
typedef __bf16 bfv2 __attribute__((ext_vector_type(2)));

constexpr int T_TOK = 32768, SEQ = 8192, DM = 1024, DEPTH = 4;
constexpr int NP = 5376;
constexpr int NIN = 8448;
constexpr float EPS = 1e-6f;
constexpr int C_QA = 0, C_IA = 512, C_LFF = 1024, C_LFB = 1536, C_ZA = 2048, C_UB = 2560, C_ZB = 3072, C_VB = 3584,
              C_QC = 4096, C_ZC = 4608, C_KC = 5120, C_VC = 5248;
constexpr int C_MERGED = 1024;
constexpr int C_GSCR = 3072;

constexpr size_t WS_PROJ = 0;
constexpr size_t WS_XB   = WS_PROJ + (size_t)T_TOK * NP * 2;
constexpr size_t WS_WIN  = WS_XB + (size_t)T_TOK * DM * 2;
constexpr size_t WS_WG   = WS_WIN + (size_t)NP * DM * 2;
constexpr size_t WS_WBR  = WS_WG + (size_t)3072 * DM * 2;
constexpr size_t WS_WOUT = WS_WBR + (size_t)3 * 1024 * 512 * 2;
constexpr size_t WS_ST   = WS_WOUT + (size_t)1024 * 1024 * 2;
constexpr size_t WS_DD   = WS_ST + (size_t)32 * 32 * 16384 * 4;
constexpr size_t WS_SSQ  = WS_DD + (size_t)32 * 32 * 128 * 4;
constexpr size_t WS_ROPE = WS_SSQ + (size_t)16 * T_TOK * 4;
constexpr size_t WS_LB   = WS_ROPE + (size_t)SEQ * 64 * 4;
constexpr size_t WS_BAR  = WS_LB + (size_t)DEPTH * 1024 * 4;
constexpr size_t WS_END  = WS_BAR + (size_t)3456 * 4;

constexpr int LDS_BYTES = 148 * 1024;
constexpr int LDS_RSB = 128 * 1024;
constexpr int LDS_XB = LDS_BYTES - 16;

struct Params {
  const float* x; const float* w_in; const float* norm_gain; const float* lb_logits; const float* hg_gain;
  const float* sg_g; const float* sg_b; const float* w_sp; const float* b_sp; const float* qg; const float* kg;
  const float* sink; const float* wba; const float* wbb; const float* wbc; const float* w_out;
  float* out; unsigned char* ws;
  int use_cg_sync; int pad0;
};

DI unsigned pk_bf16(float lo, float hi) { f32x2 v = {lo, hi}; bfv2 b = __builtin_convertvector(v, bfv2); return __builtin_bit_cast(unsigned, b); }
DI bf16_t f2bf(float f) { return (bf16_t)(pk_bf16(f, 0.f) & 0xffffu); }
DI float bf2f(unsigned short b) { return __uint_as_float(((unsigned)b) << 16); }
DI float bflo(unsigned w) { return __uint_as_float(w << 16); }
DI float bfhi(unsigned w) { return __uint_as_float(w & 0xffff0000u); }
DI unsigned short f2h(float f) { _Float16 h = (_Float16)f; return __builtin_bit_cast(unsigned short, h); }
DI float h2f(unsigned short u) { _Float16 h = __builtin_bit_cast(_Float16, u); return (float)h; }
DI float fsigmoid(float v) { return __builtin_amdgcn_rcpf(1.0f + __builtin_amdgcn_exp2f(v * -1.4426950408889634f)); }
DI float fsilu(float v) { return v * __builtin_amdgcn_rcpf(1.0f + __builtin_amdgcn_exp2f(v * -1.4426950408889634f)); }
DI float fgelu(float v) { return v * __builtin_amdgcn_rcpf(1.0f + __builtin_amdgcn_exp2f(v * (-2.3022082f - 0.1029432f * v * v))); }
DI float row_rs(const float* ssqp, int r, int fq) {
  const f32x4 a = *(const f32x4*)(ssqp + (size_t)r * 16 + fq * 4);
  float t = (a[0] + a[1]) + (a[2] + a[3]);
  t += __shfl_xor(t, 16); t += __shfl_xor(t, 32);
  return rsqrtf(t * (1.0f / 1024.0f) + EPS); }
DI float row_rs_lds(const LAS unsigned char* lds, int rl, int fq) {
  const f32x4 a = *(const LAS f32x4*)(lds + LDS_RSB + rl * 64 + fq * 16);
  float t = (a[0] + a[1]) + (a[2] + a[3]);
  t += __shfl_xor(t, 16); t += __shfl_xor(t, 32);
  return rsqrtf(t * (1.0f / 1024.0f) + EPS); }
DI f32x4 mfma16(bf16x8 a, bf16x8 b, f32x4 c) { return __builtin_amdgcn_mfma_f32_16x16x32_bf16(a, b, c, 0, 0, 0); }

DI void lds_barrier() { asm volatile("s_waitcnt lgkmcnt(0)" ::: "memory"); __builtin_amdgcn_s_barrier(); asm volatile("" ::: "memory"); }
DI int opaque_tid() { int t = threadIdx.x; asm volatile("" : "+v"(t)); return t; }
constexpr int BM = 256, BK = 64, HALF = 128, HTB = HALF * BK * 2, NXCD = 8, WGM = 8;
DI int lds_byte(int r, int c) { const int st = (r >> 4) * 2 + (c >> 5), rr = r & 15, cc = c & 31, ob = rr * 64 + cc * 2; return st * 1024 + (ob ^ (((ob >> 9) & 1) << 5)); }
DI void stage_rc(int b, int& R, int& C) { const int st = b / 1024, sb = b % 1024, swz = sb ^ (((sb >> 9) & 1) << 5); R = (st >> 1) * 16 + swz / 64; C = (st & 1) * 32 + (swz % 64) / 2; }
DI int perm32(int rho) { const int n = rho >> 4, i = rho & 15; return 8 * (i >> 2) + 4 * n + (i & 3); }

struct GUnit { const char* A; const char* B; int lda2, ldb2, nt, pm, pn, mode; };

DI void tile_order(int L, int nM, int nN, int& pm, int& pn) {
  const int nwg = nM * nN; int wgid = L;
  { const int q = nwg / NXCD, r = nwg % NXCD, xcd = wgid % NXCD, off = wgid / NXCD; wgid = (xcd < r ? xcd * (q + 1) : r * (q + 1) + (xcd - r) * q) + off; }
  const int nig = WGM * nN, gid = wgid / nig, fm = gid * WGM, gsz = (nM - fm) < WGM ? (nM - fm) : WGM;
  pm = fm + ((wgid % nig) % gsz); pn = (wgid % nig) / gsz;
}

template <int RSMODE  , class Gen, class Epi>
DI void gemm_phase(LAS unsigned char* lds, const Gen& gen, const Epi& E, const float* ssqg) {
  const int tid = opaque_tid(), wid = __builtin_amdgcn_readfirstlane(tid >> 6), lane = tid & 63, wr = wid >> 2, wc = wid & 3, fr = lane & 15, fq = lane >> 4;
  int RA[2], RB[2], CC[2];
#pragma unroll
  for (int i = 0; i < 2; ++i) { int R, C; stage_rc(tid * 16 + i * 8192, R, C); RA[i] = R; RB[i] = (R & ~31) + perm32(R & 31); CC[i] = C * 2; }
  const unsigned ldsw = (unsigned)wid * 1024u;
  const int aoff = lds_byte(wr * 64 + fr, fq * 8), boff = lds_byte(wc * 32 + fr, fq * 8);
#define G_SA(b, h) (((b) * 2 + (h)) * HTB)
#define G_SB(b, h) ((4 + (b) * 2 + (h)) * HTB)
#define G_STAGEA(bufoff, gbase, ld2) do { _Pragma("unroll") for (int _i = 0; _i < 2; ++_i) \
    __builtin_amdgcn_global_load_lds((const unsigned*)((gbase) + (unsigned)(RA[_i] * (ld2) + CC[_i])), (LAS unsigned*)(lds + (bufoff) + ldsw + _i * 8192), 16, 0, 0); } while (0)
#define G_STAGEB(bufoff, gbase, ld2) do { _Pragma("unroll") for (int _i = 0; _i < 2; ++_i) \
    __builtin_amdgcn_global_load_lds((const unsigned*)((gbase) + (unsigned)(RB[_i] * (ld2) + CC[_i])), (LAS unsigned*)(lds + (bufoff) + ldsw + _i * 8192), 16, 0, 0); } while (0)
#define G_LDA(dst, b, h) do { _Pragma("unroll") for (int m = 0; m < 4; ++m) _Pragma("unroll") for (int k = 0; k < 2; ++k) dst[m][k] = *(const LAS bf16x8*)(lds + G_SA(b, h) + aoff + m * 2048 + k * 1024); } while (0)
#define G_LDB(dst, b, h) do { _Pragma("unroll") for (int n = 0; n < 2; ++n) _Pragma("unroll") for (int k = 0; k < 2; ++k) dst[n][k] = *(const LAS bf16x8*)(lds + G_SB(b, h) + boff + n * 2048 + k * 1024); } while (0)
#define G_MMA(ai, bj, At, Bt) do { __builtin_amdgcn_s_setprio(1); _Pragma("unroll") for (int m = 0; m < 4; ++m) _Pragma("unroll") for (int n = 0; n < 2; ++n) _Pragma("unroll") for (int k = 0; k < 2; ++k) \
    acc[ai][bj][m][n] = __builtin_amdgcn_mfma_f32_16x16x32_bf16(Bt[n][k], At[m][k], acc[ai][bj][m][n], 0, 0, 0); __builtin_amdgcn_s_setprio(0); } while (0)
#define G_WAIT_V(n) asm volatile("s_waitcnt vmcnt(" #n ")" ::: "memory")
#define G_WAIT_L(n) asm volatile("s_waitcnt lgkmcnt(" #n ")" ::: "memory")
#define G_BAR __builtin_amdgcn_s_barrier()
#define G_SCHED __builtin_amdgcn_sched_barrier(0)
  GUnit cur, nxt; int ui = 0;
  if (!gen.get(0, cur)) return;
  f32x4 acc[2][2][4][2];
#pragma unroll
  for (int a = 0; a < 2; ++a)
#pragma unroll
    for (int b = 0; b < 2; ++b)
#pragma unroll
      for (int m = 0; m < 4; ++m)
#pragma unroll
        for (int n = 0; n < 2; ++n) acc[a][b][m][n] = (f32x4){0.f, 0.f, 0.f, 0.f};
  bf16x8 At[4][2], B0[2][2], B1[2][2];
  const char* cA = cur.A; const char* cB = cur.B; int clda = cur.lda2, cldb = cur.ldb2;
  constexpr size_t kstep = BK * 2;
  G_STAGEB(G_SB(0, 0), cB, cldb); G_STAGEA(G_SA(0, 0), cA, clda); G_STAGEB(G_SB(0, 1), cB + (size_t)HALF * cldb, cldb); G_STAGEA(G_SA(0, 1), cA + (size_t)HALF * clda, clda);
  if (wr == 1) G_BAR;
  G_WAIT_V(4); G_BAR;
  G_STAGEB(G_SB(1, 0), cB + kstep, cldb); G_STAGEA(G_SA(1, 0), cA + kstep, clda); G_STAGEB(G_SB(1, 1), cB + (size_t)HALF * cldb + kstep, cldb);
  G_WAIT_V(6); G_BAR;
  for (;;) {
    const bool has_next = gen.get(ui + 1, nxt);
    const char* nA = has_next ? nxt.A : cA; const char* nB = has_next ? nxt.B : cB;
    const int nlda = has_next ? nxt.lda2 : clda, nldb = has_next ? nxt.ldb2 : cldb;
    const int nt = cur.nt;
    for (int t = 0; t < nt; t += 2) {
      const bool last = (t == nt - 2);
      const char* a1 = cA + (size_t)(t + 1) * kstep;
      const char* a2 = last ? nA : cA + (size_t)(t + 2) * kstep; const char* b2 = last ? nB : cB + (size_t)(t + 2) * kstep;
      const int lda_n = last ? nlda : clda, ldb_n = last ? nldb : cldb;
      const char* a3 = a2 + kstep; const char* b3 = b2 + kstep;
      G_LDB(B0, 0, 0); G_SCHED; G_LDA(At, 0, 0); G_STAGEA(G_SA(1, 1), a1 + (size_t)HALF * clda, clda);
      if (RSMODE != 0 && t == 2 && (RSMODE == 1 || cur.mode == 0)) {
        const char* rsrc = (const char*)ssqg + (size_t)cur.pm * (BM * 64) + ldsw + (unsigned)lane * 16u;
#pragma unroll
        for (int _i = 0; _i < 2; ++_i) __builtin_amdgcn_global_load_lds((const unsigned*)(rsrc + _i * 8192), (LAS unsigned*)(lds + LDS_RSB + ldsw + _i * 8192), 16, 0, 0);
      }
      G_WAIT_L(8); G_BAR; G_WAIT_L(0); G_MMA(0, 0, At, B0); G_BAR; G_SCHED;
      G_LDB(B1, 0, 1); G_STAGEB(G_SB(0, 0), b2, ldb_n);
      G_BAR; G_WAIT_L(0); G_MMA(0, 1, At, B1); G_BAR;
      G_LDA(At, 0, 1); G_STAGEA(G_SA(0, 0), a2, lda_n);
      G_BAR; G_WAIT_L(0); G_MMA(1, 0, At, B0); G_BAR; G_SCHED;
      G_STAGEB(G_SB(0, 1), b2 + (size_t)HALF * ldb_n, ldb_n);
      G_WAIT_V(6); G_BAR; G_MMA(1, 1, At, B1); G_BAR;
      G_LDB(B0, 1, 0); G_SCHED; G_LDA(At, 1, 0); G_STAGEA(G_SA(0, 1), a2 + (size_t)HALF * lda_n, lda_n);
      G_WAIT_L(8); G_BAR; G_WAIT_L(0); G_MMA(0, 0, At, B0); G_BAR; G_SCHED;
      G_LDB(B1, 1, 1); G_STAGEB(G_SB(1, 0), b3, ldb_n);
      G_BAR; G_WAIT_L(0); G_MMA(0, 1, At, B1); G_BAR;
      G_LDA(At, 1, 1); G_STAGEA(G_SA(1, 0), a3, lda_n);
      G_BAR; G_WAIT_L(0); G_MMA(1, 0, At, B0); G_BAR; G_SCHED;
      G_STAGEB(G_SB(1, 1), b3 + (size_t)HALF * ldb_n, ldb_n);
      G_WAIT_V(6); G_BAR; G_MMA(1, 1, At, B1); G_BAR;
    }
    E(acc, cur, wr, wc, fr, fq, lds);
    if (!has_next) break;
#pragma unroll
    for (int a = 0; a < 2; ++a)
#pragma unroll
      for (int b = 0; b < 2; ++b)
#pragma unroll
        for (int m = 0; m < 4; ++m)
#pragma unroll
          for (int n = 0; n < 2; ++n) acc[a][b][m][n] = (f32x4){0.f, 0.f, 0.f, 0.f};
    cur = nxt; cA = nA; cB = nB; clda = nlda; cldb = nldb; ++ui;
  }
  G_WAIT_V(0);
  if (wr == 0) G_BAR;
  G_BAR;
#undef G_SA
#undef G_SB
#undef G_STAGEA
#undef G_STAGEB
#undef G_LDA
#undef G_LDB
#undef G_MMA
}

struct GenPlain {
  const char* A; const char* B; int lda2, ldb2, nt, nM, nN, G, c;
  DI bool get(int i, GUnit& u) const {
    const long L = (long)i * G + c; if (L >= (long)nM * nN) return false;
    int pm, pn; tile_order((int)L, nM, nN, pm, pn);
    u.A = A + (size_t)pm * BM * lda2; u.B = B + (size_t)pn * BM * ldb2; u.lda2 = lda2; u.ldb2 = ldb2; u.nt = nt; u.pm = pm; u.pn = pn; u.mode = 0; return true;
  }
};
struct GenMerge {
  const char* xb; const char* proj; const char* wg; const char* wbr; int G, c;
  DI bool get(int i, GUnit& u) const {
    const int ti = i / 6, sub = i - ti * 6, br = sub >> 1;
    const long L = (long)ti * G + c; if (L >= 512) return false;
    int pm, pn; tile_order((int)L, 128, 4, pm, pn);
    u.pm = pm; u.pn = pn;
    if ((sub & 1) == 0) { u.A = xb + (size_t)pm * BM * 2048; u.lda2 = 2048; u.B = wg + ((size_t)br * 1024 + (size_t)pn * BM) * 2048; u.ldb2 = 2048; u.nt = 16; u.mode = 0; }
    else { const int col = br == 0 ? C_QA : (br == 1 ? C_UB : C_QC);
      u.A = proj + (size_t)pm * BM * (NP * 2) + (size_t)col * 2; u.lda2 = NP * 2; u.B = wbr + ((size_t)br * 1024 + (size_t)pn * BM) * 1024; u.ldb2 = 1024; u.nt = 8; u.mode = br + 1; }
    return true;
  }
};

struct EpiProj {
  bf16_t* P; const float* ssq; const float* lb;
  DI void operator()(const f32x4 (&acc)[2][2][4][2], const GUnit& u, int wr, int wc, int fr, int fq, const LAS unsigned char* lds) const {
    const int row0 = u.pm * BM + wr * 64 + fr;
    float rs[2][4];
#pragma unroll
    for (int ai = 0; ai < 2; ++ai)
#pragma unroll
      for (int m = 0; m < 4; ++m) rs[ai][m] = row_rs_lds(lds, wr * 64 + fr + ai * HALF + m * 16, fq);
#pragma unroll
    for (int bj = 0; bj < 2; ++bj) {
      const int cb = u.pn * BM + bj * HALF; const int region = cb >> 9;
      const int col0 = cb + wc * 32 + 8 * fq;
      int act = 0;
      if (region == 2 || region == 3) act = 3;
      float lbv[8];
      if (act == 3) { const f32x4 l0 = *(const f32x4*)(lb + col0 - 1024), l1 = *(const f32x4*)(lb + col0 - 1024 + 4);
#pragma unroll
        for (int j = 0; j < 4; ++j) { lbv[j] = l0[j]; lbv[4 + j] = l1[j]; } }
#pragma unroll
      for (int ai = 0; ai < 2; ++ai)
#pragma unroll
        for (int m = 0; m < 4; ++m) {
          float v[8];
#pragma unroll
          for (int j = 0; j < 4; ++j) { v[j] = acc[ai][bj][m][0][j] * rs[ai][m]; v[4 + j] = acc[ai][bj][m][1][j] * rs[ai][m]; }
          u32x4 w;
          if (act == 3) {
            unsigned short hh[8];
#pragma unroll
            for (int j = 0; j < 8; ++j) { const float f = lbv[j] + (1.0f - lbv[j]) * fsigmoid(v[j]); hh[j] = f2h(fmaxf(__builtin_amdgcn_logf(f), -43.0f)); }
            w.x = hh[0] | ((unsigned)hh[1] << 16); w.y = hh[2] | ((unsigned)hh[3] << 16); w.z = hh[4] | ((unsigned)hh[5] << 16); w.w = hh[6] | ((unsigned)hh[7] << 16);
          } else {
            if (act == 1) {
#pragma unroll
              for (int j = 0; j < 8; ++j) v[j] = fsilu(v[j]);
            } else if (act == 2) {
#pragma unroll
              for (int j = 0; j < 8; ++j) v[j] = fgelu(v[j]);
            }
            w.x = pk_bf16(v[0], v[1]); w.y = pk_bf16(v[2], v[3]); w.z = pk_bf16(v[4], v[5]); w.w = pk_bf16(v[6], v[7]);
          }
          *(u32x4*)(P + (size_t)(row0 + ai * HALF + m * 16) * NP + col0) = w;
          asm volatile("" ::: "memory");
        }
    }
  }
};
struct EpiMerge {
  bf16_t* P; const float* ssq; unsigned char* scr;
  template <int MODE>
  DI void run(const f32x4 (&acc)[2][2][4][2], const GUnit& u, int wr, int wc, int fr, int fq, const LAS unsigned char* lds) const {
    const int row0 = u.pm * BM + wr * 64 + fr;
    unsigned voff = (unsigned)((wr * 4 + wc) * 64 + fq * 16 + fr) * 8u; asm volatile("" : "+v"(voff));
#pragma unroll
    for (int ai = 0; ai < 2; ++ai) {
      u32x2 g[4][2]; u32x4 mm[4][2];
      if (MODE >= 1) {
#pragma unroll
        for (int m = 0; m < 4; ++m)
#pragma unroll
          for (int bj = 0; bj < 2; ++bj) { const int q = (ai * 4 + m) * 2 + bj;
            g[m][bj] = *(const u32x2*)((scr + 131072 + q * 4096) + voff);
            if (MODE >= 2) mm[m][bj] = *(const u32x4*)((scr + q * 8192) + voff * 2u); }
      }
#pragma unroll
      for (int m = 0; m < 4; ++m) {
        const int r = row0 + ai * HALF + m * 16;
        float rsv = 0.f; if (MODE == 0) rsv = row_rs_lds(lds, wr * 64 + fr + ai * HALF + m * 16, fq) * -1.4426950408889634f;
#pragma unroll
        for (int bj = 0; bj < 2; ++bj) {
          const int q = (ai * 4 + m) * 2 + bj;
          u32x2* gp = (u32x2*)((scr + 131072 + q * 4096) + voff); u32x4* mp = (u32x4*)((scr + q * 8192) + voff * 2u);
          if (MODE == 0) {
            u32x2 w = {0u, 0u};
#pragma unroll
            for (int j = 0; j < 4; ++j) {
              w.x |= (unsigned)__float2uint_rn(__builtin_amdgcn_rcpf(__builtin_fmaf(__builtin_amdgcn_exp2f(acc[ai][bj][m][0][j] * rsv), 1.0f / 255.0f, 1.0f / 255.0f))) << (8 * j);
              w.y |= (unsigned)__float2uint_rn(__builtin_amdgcn_rcpf(__builtin_fmaf(__builtin_amdgcn_exp2f(acc[ai][bj][m][1][j] * rsv), 1.0f / 255.0f, 1.0f / 255.0f))) << (8 * j); }
            *gp = w;
          } else {
            const u32x2 gg = g[m][bj];
            float v[8];
#pragma unroll
            for (int j = 0; j < 4; ++j) { v[j] = acc[ai][bj][m][0][j] * ((float)((gg.x >> (8 * j)) & 0xffu) * (1.0f / 255.0f)); v[4 + j] = acc[ai][bj][m][1][j] * ((float)((gg.y >> (8 * j)) & 0xffu) * (1.0f / 255.0f)); }
            if (MODE >= 2) { const u32x4 mv = mm[m][bj];
              v[0] += bflo(mv.x); v[1] += bfhi(mv.x); v[2] += bflo(mv.y); v[3] += bfhi(mv.y); v[4] += bflo(mv.z); v[5] += bfhi(mv.z); v[6] += bflo(mv.w); v[7] += bfhi(mv.w); }
            u32x4 w; w.x = pk_bf16(v[0], v[1]); w.y = pk_bf16(v[2], v[3]); w.z = pk_bf16(v[4], v[5]); w.w = pk_bf16(v[6], v[7]);
            if (MODE == 3) *(u32x4*)(P + (size_t)r * NP + C_MERGED + u.pn * BM + bj * HALF + wc * 32 + 8 * fq) = w;
            else *mp = w;
          }
        }
      }
      asm volatile("" ::: "memory");
    }
  }
  DI void operator()(const f32x4 (&acc)[2][2][4][2], const GUnit& u, int wr, int wc, int fr, int fq, const LAS unsigned char* lds) const {
    if (u.mode == 0) run<0>(acc, u, wr, wc, fr, fq, lds); else if (u.mode == 1) run<1>(acc, u, wr, wc, fr, fq, lds); else if (u.mode == 2) run<2>(acc, u, wr, wc, fr, fq, lds); else run<3>(acc, u, wr, wc, fr, fq, lds);
  }
};
struct EpiOut {
  const float* XI; float* XO; bf16_t* XB; float* ssqn; int first, lastl;
  DI void operator()(const f32x4 (&acc)[2][2][4][2], const GUnit& u, int wr, int wc, int fr, int fq, const LAS unsigned char*) const {
    const int row0 = u.pm * BM + wr * 64 + fr;
#pragma unroll
    for (int ai = 0; ai < 2; ++ai)
#pragma unroll
      for (int mh = 0; mh < 2; ++mh) {
        f32x4 xa[2][2], xb2[2][2];
        if (first) {
#pragma unroll
          for (int mm = 0; mm < 2; ++mm)
#pragma unroll
            for (int bj = 0; bj < 2; ++bj) { const float* xi = XI + (size_t)(row0 + ai * HALF + (mh * 2 + mm) * 16) * DM + u.pn * BM + bj * HALF + wc * 32 + 8 * fq; xa[mm][bj] = *(const f32x4*)xi; xb2[mm][bj] = *(const f32x4*)(xi + 4); }
        } else {
          u32x4 xw[2][2];
#pragma unroll
          for (int mm = 0; mm < 2; ++mm)
#pragma unroll
            for (int bj = 0; bj < 2; ++bj) xw[mm][bj] = *(const u32x4*)(XB + (size_t)(row0 + ai * HALF + (mh * 2 + mm) * 16) * DM + u.pn * BM + bj * HALF + wc * 32 + 8 * fq);
#pragma unroll
          for (int mm = 0; mm < 2; ++mm)
#pragma unroll
            for (int bj = 0; bj < 2; ++bj) { xa[mm][bj] = (f32x4){bflo(xw[mm][bj].x), bfhi(xw[mm][bj].x), bflo(xw[mm][bj].y), bfhi(xw[mm][bj].y)}; xb2[mm][bj] = (f32x4){bflo(xw[mm][bj].z), bfhi(xw[mm][bj].z), bflo(xw[mm][bj].w), bfhi(xw[mm][bj].w)}; }
        }
#pragma unroll
        for (int mm = 0; mm < 2; ++mm) {
          const int m = mh * 2 + mm;
          const int r = row0 + ai * HALF + m * 16; float ss = 0.f;
#pragma unroll
          for (int bj = 0; bj < 2; ++bj) {
            const int col0 = u.pn * BM + bj * HALF + wc * 32 + 8 * fq;
            f32x4 x0 = xa[mm][bj] + acc[ai][bj][m][0], x1 = xb2[mm][bj] + acc[ai][bj][m][1];
            if (lastl) { float* xp = XO + (size_t)r * DM + col0; *(f32x4*)xp = x0; *(f32x4*)(xp + 4) = x1; }
            else {
              u32x4 w; w.x = pk_bf16(x0[0], x0[1]); w.y = pk_bf16(x0[2], x0[3]); w.z = pk_bf16(x1[0], x1[1]); w.w = pk_bf16(x1[2], x1[3]);
              *(u32x4*)(XB + (size_t)r * DM + col0) = w;
              ss += (x0[0] * x0[0] + x0[1] * x0[1]) + (x0[2] * x0[2] + x0[3] * x0[3]) + (x1[0] * x1[0] + x1[1] * x1[1]) + (x1[2] * x1[2] + x1[3] * x1[3]);
            }
          }
          if (!lastl) { ss += __shfl_xor(ss, 16); ss += __shfl_xor(ss, 32);
            if (fq == 0) ssqn[(size_t)r * 16 + u.pn * 4 + wc] = ss; }
        }
        asm volatile("" ::: "memory");
      }
  }
};

DI int inproj_orig_col(int n) {
  const int mb = n >> 7, w = n & 127; int ob;
  if (mb < 4) ob = mb; else if (mb < 8) ob = mb + 8; else if (mb < 16) ob = mb - 4; else if (mb < 24) ob = mb;
  else if (mb < 28) ob = mb + 4; else if (mb < 32) ob = mb - 4; else if (mb < 36) ob = mb; else if (mb < 40) ob = mb + 2; else ob = mb - 4;
  return ob * 128 + w;
}
DI void convert_w(const float* W, int ldw, int K, bf16_t* Wt, int Nn, int mapmode, int colbase, const float* gain, long gtid, long gthreads) {
  const long ntask = (long)Nn * (K / 8);
  for (long task0 = gtid; task0 < ntask; task0 += 2 * gthreads) {
    float v[2][8]; int k8s[2], ns[2]; bool ok[2];
#pragma unroll
    for (int u = 0; u < 2; ++u) {
      const long task = task0 + u * gthreads; ok[u] = task < ntask; const long tk = ok[u] ? task : task0;
      const int k8 = (int)(tk / Nn), n = (int)(tk - (long)k8 * Nn); k8s[u] = k8; ns[u] = n;
      const int oc = mapmode ? inproj_orig_col(n) : colbase + n;
#pragma unroll
      for (int i = 0; i < 8; ++i) v[u][i] = W[(size_t)(k8 * 8 + i) * ldw + oc];
    }
#pragma unroll
    for (int u = 0; u < 2; ++u) {
      const int k8 = k8s[u], n = ns[u];
      if (gain) { const f32x4 g0 = *(const f32x4*)(gain + k8 * 8), g1 = *(const f32x4*)(gain + k8 * 8 + 4);
#pragma unroll
        for (int i = 0; i < 4; ++i) { v[u][i] *= g0[i]; v[u][4 + i] *= g1[i]; } }
      u32x4 w; w.x = pk_bf16(v[u][0], v[u][1]); w.y = pk_bf16(v[u][2], v[u][3]); w.z = pk_bf16(v[u][4], v[u][5]); w.w = pk_bf16(v[u][6], v[u][7]);
      if (ok[u]) *(u32x4*)(Wt + (size_t)n * K + k8 * 8) = w;
    }
  }
}

typedef short s16x4 __attribute__((ext_vector_type(4)));
DI bf16x8 tr_pair(const LAS bf16_t* p0, const LAS bf16_t* p1) {
  const s16x4 a = __builtin_amdgcn_ds_read_tr16_b64_v4i16((LAS s16x4*)p0), b = __builtin_amdgcn_ds_read_tr16_b64_v4i16((LAS s16x4*)p1);
  return (bf16x8){a[0], a[1], a[2], a[3], b[0], b[1], b[2], b[3]};
}
constexpr int SG_LD = 272;
DI void sgu_item(LAS unsigned char* lds, const Params& p, int l, int item) {
  bf16_t* P = (bf16_t*)(p.ws + WS_PROJ);
  const int tid = opaque_tid(), wid = __builtin_amdgcn_readfirstlane(tid >> 6), lane = tid & 63, fr = lane & 15, fq = lane >> 4;
  const size_t tok0 = (size_t)item * 128;
  LAS float* stat = (LAS float*)lds;
  LAS bf16_t* vn = (LAS bf16_t*)(lds + 1024);
  LAS float* lng = (LAS float*)(lds + 1024 + 128 * SG_LD * 2); LAS float* lnb = lng + 512;
  __syncthreads();
  lng[tid] = p.sg_g[l * 512 + tid]; lnb[tid] = p.sg_b[l * 512 + tid];
  {
    u32x4 w[16];
#pragma unroll
    for (int i = 0; i < 16; ++i) w[i] = *(const u32x4*)(P + (tok0 + wid * 16 + i) * NP + C_VB + lane * 8);
#pragma unroll
    for (int i = 0; i < 16; ++i) {
      const float v[8] = {fgelu(bflo(w[i].x)), fgelu(bfhi(w[i].x)), fgelu(bflo(w[i].y)), fgelu(bfhi(w[i].y)), fgelu(bflo(w[i].z)), fgelu(bfhi(w[i].z)), fgelu(bflo(w[i].w)), fgelu(bfhi(w[i].w))};
      float sm = 0.f;
#pragma unroll
      for (int j = 0; j < 8; ++j) sm += v[j];
#pragma unroll
      for (int o = 32; o >= 1; o >>= 1) sm += __shfl_xor(sm, o);
      const float mu = sm * (1.0f / 512.0f); float q = 0.f;
#pragma unroll
      for (int j = 0; j < 8; ++j) { const float d = v[j] - mu; q += d * d; }
#pragma unroll
      for (int o = 32; o >= 1; o >>= 1) q += __shfl_xor(q, o);
      if (lane == 0) { stat[(wid * 16 + i) * 2] = mu; stat[(wid * 16 + i) * 2 + 1] = rsqrtf(q * (1.0f / 512.0f) + EPS); }
    }
  }
  __syncthreads();
  const int s_row = tid >> 2, cq = tid & 3;
  const float mu = stat[s_row * 2], rstd = stat[s_row * 2 + 1];
  for (int hf = 0; hf < 2; ++hf) {
    {
      u32x4 w[8];
#pragma unroll
      for (int o = 0; o < 8; ++o) w[o] = *(const u32x4*)(P + (tok0 + s_row) * NP + C_VB + hf * 256 + cq * 64 + o * 8);
#pragma unroll
      for (int o = 0; o < 8; ++o) {
        const int c0 = hf * 256 + cq * 64 + o * 8;
        const f32x4 g0 = *(const LAS f32x4*)(lng + c0), g1 = *(const LAS f32x4*)(lng + c0 + 4), b0 = *(const LAS f32x4*)(lnb + c0), b1 = *(const LAS f32x4*)(lnb + c0 + 4);
        u32x4 r;
        r.x = pk_bf16((fgelu(bflo(w[o].x)) - mu) * rstd * g0[0] + b0[0], (fgelu(bfhi(w[o].x)) - mu) * rstd * g0[1] + b0[1]);
        r.y = pk_bf16((fgelu(bflo(w[o].y)) - mu) * rstd * g0[2] + b0[2], (fgelu(bfhi(w[o].y)) - mu) * rstd * g0[3] + b0[3]);
        r.z = pk_bf16((fgelu(bflo(w[o].z)) - mu) * rstd * g1[0] + b1[0], (fgelu(bfhi(w[o].z)) - mu) * rstd * g1[1] + b1[1]);
        r.w = pk_bf16((fgelu(bflo(w[o].w)) - mu) * rstd * g1[2] + b1[2], (fgelu(bfhi(w[o].w)) - mu) * rstd * g1[3] + b1[3]);
        *(LAS u32x4*)(vn + s_row * SG_LD + cq * 64 + o * 8) = r;
      }
    }
    __syncthreads();
    const int t = wid * 16 + fr;
#pragma unroll
    for (int gg = 0; gg < 2; ++gg) {
      const int g = hf * 2 + gg;
      const float* wrow = p.w_sp + (((size_t)l * 4 + g) * 128 + t) * 128;
      bf16x8 bfrag[4];
      f32x4 wa[4], wb[4];
#pragma unroll
      for (int kk = 0; kk < 4; ++kk) { wa[kk] = *(const f32x4*)(wrow + kk * 32 + fq * 4); wb[kk] = *(const f32x4*)(wrow + kk * 32 + 16 + fq * 4); }
      const float bias = p.b_sp[((size_t)l * 4 + g) * 128 + t];
      u32x2 uu[8], zz[8];
#pragma unroll
      for (int ct = 0; ct < 8; ++ct) { const size_t off = (tok0 + t) * NP + g * 128 + ct * 16 + fq * 4; uu[ct] = *(const u32x2*)(P + off + C_UB); zz[ct] = *(const u32x2*)(P + off + C_ZB); }
      asm volatile("" ::: "memory");
#pragma unroll
      for (int kk = 0; kk < 4; ++kk) { u32x4 w; w.x = pk_bf16(wa[kk][0], wa[kk][1]); w.y = pk_bf16(wa[kk][2], wa[kk][3]); w.z = pk_bf16(wb[kk][0], wb[kk][1]); w.w = pk_bf16(wb[kk][2], wb[kk][3]); bfrag[kk] = __builtin_bit_cast(bf16x8, w); }
#pragma unroll
      for (int ct = 0; ct < 8; ++ct) {
        f32x4 acc = {0.f, 0.f, 0.f, 0.f};
#pragma unroll
        for (int kk = 0; kk < 4; ++kk) {
          const LAS bf16_t* base = vn + (kk * 32 + fq * 4 + (fr >> 2)) * SG_LD + gg * 128 + ct * 16 + (fr & 3) * 4;
          const bf16x8 a = tr_pair(base, base + 16 * SG_LD);
          acc = mfma16(a, bfrag[kk], acc);
        }
        const size_t off = (tok0 + t) * NP + g * 128 + ct * 16 + fq * 4;
        const float o0 = fgelu(bflo(uu[ct].x)) * (acc[0] + bias) * fsilu(bflo(zz[ct].x)), o1 = fgelu(bfhi(uu[ct].x)) * (acc[1] + bias) * fsilu(bfhi(zz[ct].x));
        const float o2 = fgelu(bflo(uu[ct].y)) * (acc[2] + bias) * fsilu(bflo(zz[ct].y)), o3 = fgelu(bfhi(uu[ct].y)) * (acc[3] + bias) * fsilu(bfhi(zz[ct].y));
        u32x2 w; w.x = pk_bf16(o0, o1); w.y = pk_bf16(o2, o3);
        *(u32x2*)(P + off + C_UB) = w;
      }
    }
    __syncthreads();
  }
}

constexpr int AT_KLD = 80;
constexpr int AT_VLD = 80;
DI void rope8(const float (&x1)[8], const float (&x2)[8], float rstd, const float* g1, const float* g2, const float* cs, u32x4& o0, u32x4& o1) {
  const f32x4 c0 = *(const f32x4*)cs, c1 = *(const f32x4*)(cs + 4), s0 = *(const f32x4*)(cs + 32), s1 = *(const f32x4*)(cs + 36);
  const f32x4 ga0 = *(const f32x4*)g1, ga1 = *(const f32x4*)(g1 + 4), gb0 = *(const f32x4*)g2, gb1 = *(const f32x4*)(g2 + 4);
  float y1[8], y2[8];
#pragma unroll
  for (int j = 0; j < 8; ++j) {
    const float c = j < 4 ? c0[j & 3] : c1[j & 3], sn = j < 4 ? s0[j & 3] : s1[j & 3];
    const float a = x1[j] * rstd * (j < 4 ? ga0[j & 3] : ga1[j & 3]), bb = x2[j] * rstd * (j < 4 ? gb0[j & 3] : gb1[j & 3]);
    y1[j] = a * c - bb * sn; y2[j] = bb * c + a * sn;
  }
  o0.x = pk_bf16(y1[0], y1[1]); o0.y = pk_bf16(y1[2], y1[3]); o0.z = pk_bf16(y1[4], y1[5]); o0.w = pk_bf16(y1[6], y1[7]);
  o1.x = pk_bf16(y2[0], y2[1]); o1.y = pk_bf16(y2[2], y2[3]); o1.z = pk_bf16(y2[4], y2[5]); o1.w = pk_bf16(y2[6], y2[7]);
}
DI void attn_item(LAS unsigned char* lds, const Params& p, int l, int item) {
  bf16_t* P = (bf16_t*)(p.ws + WS_PROJ);
  const float* ropec = (const float*)(p.ws + WS_ROPE);
  const int tid = opaque_tid(), wid = __builtin_amdgcn_readfirstlane(tid >> 6), lane = tid & 63, fr = lane & 15, fq = lane >> 4;
  const int blk = item & 63, kvh = (item >> 6) & 1, b = item >> 7;
  const size_t tokb = (size_t)b * SEQ;
  LAS bf16_t* Ks = (LAS bf16_t*)lds;
  LAS bf16_t* Vs = (LAS bf16_t*)(lds + 384 * AT_KLD * 2);
  const float* qg = p.qg + l * 64; const float* kg = p.kg + l * 64;
  __syncthreads();
  {
    u32x4 w[6];
#pragma unroll
    for (int it = 0; it < 6; ++it) { const int task = it * 512 + tid; const int kk = task >> 3, o8 = task & 7; const int pos = blk * 128 - 128 + kk;
      const int pc = pos < 0 ? 0 : (pos >= SEQ ? SEQ - 1 : pos);
      w[it] = *(const u32x4*)(P + (tokb + pc) * NP + C_VC + kvh * 64 + o8 * 8); }
#pragma unroll
    for (int it = 0; it < 6; ++it) { const int task = it * 512 + tid; const int kk = task >> 3, o8 = task & 7; *(LAS u32x4*)(Vs + kk * AT_VLD + o8 * 8) = w[it]; }
  }
  {
    u32x4 w0[3], w1[3];
#pragma unroll
    for (int it = 0; it < 3; ++it) { const int task = it * 512 + tid; const int kk = task >> 2, o = task & 3; const int pos = blk * 128 - 128 + kk;
      const int pc = pos < 0 ? 0 : (pos >= SEQ ? SEQ - 1 : pos);
      const bf16_t* src = P + (tokb + pc) * NP + C_KC + kvh * 64 + o * 8; w0[it] = *(const u32x4*)src; w1[it] = *(const u32x4*)(src + 32); }
#pragma unroll
    for (int it = 0; it < 3; ++it) { const int task = it * 512 + tid; const int kk = task >> 2, o = task & 3; const int pos = blk * 128 - 128 + kk;
      const float x1[8] = {bflo(w0[it].x), bfhi(w0[it].x), bflo(w0[it].y), bfhi(w0[it].y), bflo(w0[it].z), bfhi(w0[it].z), bflo(w0[it].w), bfhi(w0[it].w)};
      const float x2[8] = {bflo(w1[it].x), bfhi(w1[it].x), bflo(w1[it].y), bfhi(w1[it].y), bflo(w1[it].z), bfhi(w1[it].z), bflo(w1[it].w), bfhi(w1[it].w)};
      float ss = 0.f;
#pragma unroll
      for (int j = 0; j < 8; ++j) ss += x1[j] * x1[j] + x2[j] * x2[j];
      ss += __shfl_xor(ss, 1); ss += __shfl_xor(ss, 2);
      const float rstd = rsqrtf(ss * (1.0f / 64.0f) + EPS);
      const int pc = pos < 0 ? 0 : (pos >= SEQ ? SEQ - 1 : pos);
      u32x4 o0, o1; rope8(x1, x2, rstd, kg + o * 8, kg + 32 + o * 8, ropec + (size_t)pc * 64 + o * 8, o0, o1);
      *(LAS u32x4*)(Ks + kk * AT_KLD + o * 8) = o0; *(LAS u32x4*)(Ks + kk * AT_KLD + 32 + o * 8) = o1; }
  }
  float gq = fabsf(qg[lane]), gk = fabsf(kg[lane]);
#pragma unroll
  for (int o = 32; o >= 1; o >>= 1) { gq = fmaxf(gq, __shfl_xor(gq, o)); gk = fmaxf(gk, __shfl_xor(gk, o)); }
  const int hq = kvh * 4 + (wid & 3), half = wid >> 2;
  const float sinkv = p.sink[l * 8 + hq];
  const float mshift = fmaxf(8.0f * gq * gk, sinkv) * 1.4426950408889634f;
  bf16x8 qf[4][2];
  {
    u32x4 w0[4], w1[4];
#pragma unroll
    for (int qt = 0; qt < 4; ++qt) { const int pos = blk * 128 + half * 64 + qt * 16 + fr; const bf16_t* src = P + (tokb + pos) * NP + C_QC + hq * 64 + fq * 8; w0[qt] = *(const u32x4*)src; w1[qt] = *(const u32x4*)(src + 32); }
#pragma unroll
    for (int qt = 0; qt < 4; ++qt) {
      const int pos = blk * 128 + half * 64 + qt * 16 + fr;
      const float x1[8] = {bflo(w0[qt].x), bfhi(w0[qt].x), bflo(w0[qt].y), bfhi(w0[qt].y), bflo(w0[qt].z), bfhi(w0[qt].z), bflo(w0[qt].w), bfhi(w0[qt].w)};
      const float x2[8] = {bflo(w1[qt].x), bfhi(w1[qt].x), bflo(w1[qt].y), bfhi(w1[qt].y), bflo(w1[qt].z), bfhi(w1[qt].z), bflo(w1[qt].w), bfhi(w1[qt].w)};
      float ss = 0.f;
#pragma unroll
      for (int j = 0; j < 8; ++j) ss += x1[j] * x1[j] + x2[j] * x2[j];
      ss += __shfl_xor(ss, 16); ss += __shfl_xor(ss, 32);
      const float rstd = rsqrtf(ss * (1.0f / 64.0f) + EPS) * (0.125f * 1.4426950408889634f);
      u32x4 o0, o1; rope8(x1, x2, rstd, qg + fq * 8, qg + 32 + fq * 8, ropec + (size_t)pos * 64 + fq * 8, o0, o1);
      qf[qt][0] = __builtin_bit_cast(bf16x8, o0); qf[qt][1] = __builtin_bit_cast(bf16x8, o1);
    }
  }
  __syncthreads();
  f32x4 oacc[4][4];
  float lsum[4] = {0.f, 0.f, 0.f, 0.f};
#pragma unroll
  for (int a = 0; a < 4; ++a)
#pragma unroll
    for (int c = 0; c < 4; ++c) oacc[a][c] = (f32x4){0.f, 0.f, 0.f, 0.f};
  const int qs = half * 64;
  for (int kp = 0; kp < 12; ++kp) {
    const int k0 = kp * 32 - 128;
    if (k0 + 31 < qs - 128 || k0 > qs + 63 + 128) continue;
    const int kabs0 = blk * 128 + k0;
    if (kabs0 + 31 < 0 || kabs0 >= SEQ) continue;
    bf16x8 kf[2][2];
#pragma unroll
    for (int kt = 0; kt < 2; ++kt)
#pragma unroll
      for (int hh = 0; hh < 2; ++hh) kf[kt][hh] = *(const LAS bf16x8*)(Ks + (kp * 32 + kt * 16 + fr) * AT_KLD + hh * 32 + fq * 8);
    bf16x8 vf[4];
#pragma unroll
    for (int dt = 0; dt < 4; ++dt) { const LAS bf16_t* base = Vs + (kp * 32 + fq * 4 + (fr >> 2)) * AT_VLD + dt * 16 + (fr & 3) * 4; vf[dt] = tr_pair(base, base + 16 * AT_VLD); }
#pragma unroll
    for (int qt = 0; qt < 4; ++qt) {
      const int q0 = qs + qt * 16;
      const bool interior = (k0 + 31 - q0 <= 128) && (q0 + 15 - k0 <= 128) && (kabs0 >= 0) && (kabs0 + 31 < SEQ);
      const int qrel = q0 + fr;
      float pv[8];
#pragma unroll
      for (int kt = 0; kt < 2; ++kt) {
        f32x4 sc = {-mshift, -mshift, -mshift, -mshift};
        sc = mfma16(kf[kt][0], qf[qt][0], sc); sc = mfma16(kf[kt][1], qf[qt][1], sc);
        if (interior) {
#pragma unroll
          for (int j = 0; j < 4; ++j) { const float e = __builtin_amdgcn_exp2f(sc[j]); pv[kt * 4 + j] = e; lsum[qt] += e; }
        } else {
#pragma unroll
          for (int j = 0; j < 4; ++j) {
            const int krel = k0 + kt * 16 + fq * 4 + j; const int kab = blk * 128 + krel; const int d = krel - qrel;
            const bool ok = (d <= 128) && (d >= -128) && (kab >= 0) && (kab < SEQ);
            const float e = ok ? __builtin_amdgcn_exp2f(sc[j]) : 0.f;
            pv[kt * 4 + j] = e; lsum[qt] += e;
          }
        }
      }
      u32x4 pw; pw.x = pk_bf16(pv[0], pv[1]); pw.y = pk_bf16(pv[2], pv[3]); pw.z = pk_bf16(pv[4], pv[5]); pw.w = pk_bf16(pv[6], pv[7]);
      const bf16x8 pb = __builtin_bit_cast(bf16x8, pw);
#pragma unroll
      for (int dt = 0; dt < 4; ++dt) oacc[dt][qt] = mfma16(vf[dt], pb, oacc[dt][qt]);
    }
  }
  const float esink = __builtin_amdgcn_exp2f(sinkv * 1.4426950408889634f - mshift);
  u32x2 zz[4][4];
#pragma unroll
  for (int qt = 0; qt < 4; ++qt)
#pragma unroll
    for (int dt = 0; dt < 4; ++dt) { const int pos = blk * 128 + half * 64 + qt * 16 + fr; zz[qt][dt] = *(const u32x2*)(P + (tokb + pos) * NP + hq * 64 + dt * 16 + fq * 4 + C_ZC); }
#pragma unroll
  for (int qt = 0; qt < 4; ++qt) {
    float ls = lsum[qt]; ls += __shfl_xor(ls, 16); ls += __shfl_xor(ls, 32);
    const float inv = 1.0f / (ls + esink);
    const int pos = blk * 128 + half * 64 + qt * 16 + fr;
#pragma unroll
    for (int dt = 0; dt < 4; ++dt) {
      const size_t off = (tokb + pos) * NP + hq * 64 + dt * 16 + fq * 4;
      const u32x2 z = zz[qt][dt];
      u32x2 w; w.x = pk_bf16(oacc[dt][qt][0] * inv * fsilu(bflo(z.x)), oacc[dt][qt][1] * inv * fsilu(bfhi(z.x))); w.y = pk_bf16(oacc[dt][qt][2] * inv * fsilu(bflo(z.y)), oacc[dt][qt][3] * inv * fsilu(bfhi(z.y)));
      *(u32x2*)(P + off + C_QC) = w;
    }
  }
}

constexpr int SCR = 512, NSC = SEQ / SCR, NSUB = SCR / 64;
constexpr int H_QLD = 144, H_TLD = 80;
constexpr int H_QS = 0, H_KS = H_QS + 64 * H_QLD * 2, H_KT = H_KS + 64 * H_QLD * 2, H_VT = H_KT + 128 * H_TLD * 2, H_ST = H_VT + 128 * H_TLD * 2,
              H_SEG = H_ST + 128 * H_QLD * 2, H_SSQ = H_SEG + 2 * 4 * 128 * 4, H_GN = H_SSQ + 2 * 64 * 4, H_END = H_GN + 128 * 4;
static_assert(H_END <= LDS_BYTES, "hgrn lds");

template <bool OUT>
DI void hgrn_super(LAS unsigned char* lds, const Params& p, int l, int b, int h, int nn, int dir, f32x4 (&S)[8], float& btot) {
  bf16_t* P = (bf16_t*)(p.ws + WS_PROJ);
  const int tid = opaque_tid(), wid = __builtin_amdgcn_readfirstlane(tid >> 6), lane = tid & 63, fr = lane & 15, fq = lane >> 4;
  const int d = tid & 127, seg = tid >> 7;
  LAS bf16_t* Qs = (LAS bf16_t*)(lds + H_QS); LAS bf16_t* Ks = (LAS bf16_t*)(lds + H_KS); LAS bf16_t* KT = (LAS bf16_t*)(lds + H_KT);
  LAS bf16_t* Vt = (LAS bf16_t*)(lds + H_VT); LAS bf16_t* St = (LAS bf16_t*)(lds + H_ST); LAS float* segtot2 = (LAS float*)(lds + H_SEG); LAS float* ssqb = (LAS float*)(lds + H_SSQ);
  const size_t tokbase = (size_t)b * SEQ + (size_t)nn * SCR;
  const int lfcol = (dir ? C_LFB : C_LFF) + h * 128;
  LAS float* gnl = (LAS float*)(lds + H_GN);
  if (OUT && dir == 1 && tid < 128) gnl[tid] = p.hg_gain[(size_t)l * 512 + h * 128 + tid];
  unsigned short lfr[16], vv[16], qr[16];
  const char* hbase = (const char*)(P + tokbase * NP + h * 128);
  const unsigned lfo = (unsigned)((dir ? C_LFB : C_LFF) * 2), iao = (unsigned)(C_IA * 2);
  const int rstep = dir ? -(NP * 2) : (NP * 2);
#define H_LOADS(CC) do { const int r0_ = (CC) * 64 + seg * 16; unsigned vo_ = (unsigned)((dir ? (SCR - 1) - r0_ : r0_) * (NP * 2) + d * 2); \
    _Pragma("unroll") for (int i = 0; i < 16; ++i) { const char* a_ = hbase + vo_; lfr[i] = *(const bf16_t*)(a_ + lfo); vv[i] = *(const bf16_t*)(a_ + iao); if (OUT) qr[i] = *(const bf16_t*)a_; vo_ += (unsigned)rstep; } } while (0)
  H_LOADS(0);
  for (int cc = 0; cc < NSUB; ++cc) {
    float lfv[16], loc[16], qv[16];
    float run = 0.f;
#pragma unroll
    for (int i = 0; i < 16; ++i) { lfv[i] = h2f(lfr[i]); if (OUT) qv[i] = bf2f(qr[i]); run += lfv[i]; loc[i] = run; }
    LAS float* segtot = segtot2 + (cc & 1) * 512;
    segtot[seg * 128 + d] = run;
    lds_barrier();
    {
      const float s0 = segtot[d], s1 = segtot[128 + d], s2 = segtot[256 + d], s3 = segtot[384 + d];
      const float bmid = s0 + s1, bend = bmid + s2 + s3;
      const float off = (seg > 0 ? s0 : 0.f) + (seg > 1 ? s1 : 0.f) + (seg > 2 ? s2 : 0.f);
      btot += bend;
      const float dof = off - bmid;
      unsigned ktw[8];
#pragma unroll
      for (int i = 0; i < 16; i += 2) {
        const float d0 = dof + loc[i], d1 = dof + loc[i + 1];
        const float k0 = 1.0f - __builtin_amdgcn_exp2f(lfv[i]), k1 = 1.0f - __builtin_amdgcn_exp2f(lfv[i + 1]);
        const unsigned kw = pk_bf16(k0 * __builtin_amdgcn_exp2f(fminf(-d0, 115.f)), k1 * __builtin_amdgcn_exp2f(fminf(-d1, 115.f)));
        ktw[i >> 1] = kw;
        if (OUT) { const int r = seg * 16 + i;
          const unsigned qw = pk_bf16(qv[i] * __builtin_amdgcn_exp2f(fminf(d0, 115.f)), qv[i + 1] * __builtin_amdgcn_exp2f(fminf(d1, 115.f)));
          Ks[r * H_QLD + d] = (bf16_t)(kw & 0xffffu); Ks[(r + 1) * H_QLD + d] = (bf16_t)(kw >> 16);
          Qs[r * H_QLD + d] = (bf16_t)(qw & 0xffffu); Qs[(r + 1) * H_QLD + d] = (bf16_t)(qw >> 16); }
      }
      u32x4 w0, w1;
      w0.x = ktw[0]; w0.y = ktw[1]; w0.z = ktw[2]; w0.w = ktw[3]; w1.x = ktw[4]; w1.y = ktw[5]; w1.z = ktw[6]; w1.w = ktw[7];
      *(LAS u32x4*)(KT + d * H_TLD + seg * 16) = w0; *(LAS u32x4*)(KT + d * H_TLD + seg * 16 + 8) = w1;
      w0.x = vv[0] | ((unsigned)vv[1] << 16); w0.y = vv[2] | ((unsigned)vv[3] << 16); w0.z = vv[4] | ((unsigned)vv[5] << 16); w0.w = vv[6] | ((unsigned)vv[7] << 16);
      w1.x = vv[8] | ((unsigned)vv[9] << 16); w1.y = vv[10] | ((unsigned)vv[11] << 16); w1.z = vv[12] | ((unsigned)vv[13] << 16); w1.w = vv[14] | ((unsigned)vv[15] << 16);
      *(LAS u32x4*)(Vt + d * H_TLD + seg * 16) = w0; *(LAS u32x4*)(Vt + d * H_TLD + seg * 16 + 8) = w1;
    }
    if (cc < NSUB - 1) H_LOADS(cc + 1);
    float e1[4], e2[4], em[4];
#pragma unroll
    for (int j = 0; j < 4; ++j) { const int dk = wid * 16 + fq * 4 + j; const float s0 = segtot[dk], s1 = segtot[128 + dk], s2 = segtot[256 + dk], s3 = segtot[384 + dk];
      em[j] = __builtin_amdgcn_exp2f(s0 + s1); e2[j] = __builtin_amdgcn_exp2f(s2 + s3); e1[j] = __builtin_amdgcn_exp2f(s0 + s1 + s2 + s3); }
    if (OUT) {
#pragma unroll
      for (int dvt = 0; dvt < 8; ++dvt) { u32x2 w; w.x = pk_bf16(S[dvt][0] * em[0], S[dvt][1] * em[1]); w.y = pk_bf16(S[dvt][2] * em[2], S[dvt][3] * em[3]);
        *(LAS u32x2*)(St + (dvt * 16 + fr) * H_QLD + wid * 16 + fq * 4) = w; }
    }
    lds_barrier();
    f32x4 oo[4];
    const int tt = wid & 3, dh = wid >> 2;
    u32x2 zzv[4]; unsigned long long ofv[4];
    if (OUT && dir == 1) {
      const int r = cc * 64 + tt * 16 + fr; const size_t tok = tokbase + (size_t)((SCR - 1) - r);
#pragma unroll
      for (int i = 0; i < 4; ++i) { const int col = h * 128 + dh * 64 + i * 16 + fq * 4;
        zzv[i] = *(const u32x2*)(P + tok * NP + C_ZA + col);
        ofv[i] = __hip_atomic_load((const unsigned long long*)(P + tok * NP + C_LFF + col), __ATOMIC_RELAXED, __HIP_MEMORY_SCOPE_AGENT); }
    }
    if (OUT) {
      bf16x8 qf[4];
#pragma unroll
      for (int kk = 0; kk < 4; ++kk) qf[kk] = *(const LAS bf16x8*)(Qs + (tt * 16 + fr) * H_QLD + kk * 32 + fq * 8);
      f32x4 pt[4];
#pragma unroll
      for (int st = 0; st < 4; ++st) {
        pt[st] = (f32x4){0.f, 0.f, 0.f, 0.f};
        if (st <= tt) {
          f32x4 a = {0.f, 0.f, 0.f, 0.f};
#pragma unroll
          for (int kk = 0; kk < 4; ++kk) { const bf16x8 kf = *(const LAS bf16x8*)(Ks + (st * 16 + fr) * H_QLD + kk * 32 + fq * 8); a = mfma16(kf, qf[kk], a); }
#pragma unroll
          for (int j = 0; j < 4; ++j) pt[st][j] = (st * 16 + fq * 4 + j <= tt * 16 + fr) ? a[j] : 0.f;
        }
      }
      bf16x8 pb[2];
#pragma unroll
      for (int pp = 0; pp < 2; ++pp) { u32x4 w; w.x = pk_bf16(pt[2 * pp][0], pt[2 * pp][1]); w.y = pk_bf16(pt[2 * pp][2], pt[2 * pp][3]); w.z = pk_bf16(pt[2 * pp + 1][0], pt[2 * pp + 1][1]); w.w = pk_bf16(pt[2 * pp + 1][2], pt[2 * pp + 1][3]);
        pb[pp] = __builtin_bit_cast(bf16x8, w); }
#pragma unroll
      for (int i = 0; i < 4; ++i) {
        const int dvt = dh * 4 + i; f32x4 a = {0.f, 0.f, 0.f, 0.f};
#pragma unroll
        for (int pp = 0; pp < 2; ++pp) if (2 * pp <= tt) {
          const bf16x4 v0 = *(const LAS bf16x4*)(Vt + (dvt * 16 + fr) * H_TLD + pp * 32 + fq * 4), v1 = *(const LAS bf16x4*)(Vt + (dvt * 16 + fr) * H_TLD + pp * 32 + 16 + fq * 4);
          const bf16x8 vf = {v0[0], v0[1], v0[2], v0[3], v1[0], v1[1], v1[2], v1[3]};
          a = mfma16(vf, pb[pp], a); }
#pragma unroll
        for (int kk = 0; kk < 4; ++kk) { const bf16x8 sf = *(const LAS bf16x8*)(St + (dvt * 16 + fr) * H_QLD + kk * 32 + fq * 8); a = mfma16(sf, qf[kk], a); }
        oo[i] = a;
      }
      const int r = cc * 64 + tt * 16 + fr; const size_t tok = tokbase + (dir ? (SCR - 1) - r : r);
      if (dir == 0) {
#pragma unroll
        for (int i = 0; i < 4; ++i) { u32x2 w; w.x = pk_bf16(oo[i][0], oo[i][1]); w.y = pk_bf16(oo[i][2], oo[i][3]);
          *(u32x2*)(P + tok * NP + C_LFF + h * 128 + dh * 64 + i * 16 + fq * 4) = w; }
      } else {
        float ss = 0.f;
#pragma unroll
        for (int i = 0; i < 4; ++i) {
          const unsigned long long ww = ofv[i];
          const unsigned lo = (unsigned)ww, hi = (unsigned)(ww >> 32);
          oo[i][0] += bflo(lo); oo[i][1] += bfhi(lo); oo[i][2] += bflo(hi); oo[i][3] += bfhi(hi);
          ss += (oo[i][0] * oo[i][0] + oo[i][1] * oo[i][1]) + (oo[i][2] * oo[i][2] + oo[i][3] * oo[i][3]);
        }
        ss += __shfl_xor(ss, 16); ss += __shfl_xor(ss, 32);
        if (fq == 0) ssqb[dh * 64 + tt * 16 + fr] = ss;
      }
    }
#pragma unroll
    for (int dvt = 0; dvt < 8; ++dvt) {
      f32x4 a = {0.f, 0.f, 0.f, 0.f};
#pragma unroll
      for (int kk = 0; kk < 2; ++kk) { const bf16x8 kf = *(const LAS bf16x8*)(KT + (wid * 16 + fr) * H_TLD + kk * 32 + fq * 8), vf = *(const LAS bf16x8*)(Vt + (dvt * 16 + fr) * H_TLD + kk * 32 + fq * 8);
        a = mfma16(kf, vf, a); }
#pragma unroll
      for (int j = 0; j < 4; ++j) S[dvt][j] = e1[j] * S[dvt][j] + e2[j] * a[j];
    }
    if (OUT && dir == 1) {
      lds_barrier();
      const int r = cc * 64 + tt * 16 + fr; const size_t tok = tokbase + (size_t)((SCR - 1) - r);
      const float tot = ssqb[tt * 16 + fr] + ssqb[64 + tt * 16 + fr];
      const float rs = rsqrtf(tot * (1.0f / 128.0f) + EPS);
#pragma unroll
      for (int i = 0; i < 4; ++i) {
        const int col = h * 128 + dh * 64 + i * 16 + fq * 4;
        const f32x4 gn = *(const LAS f32x4*)(gnl + dh * 64 + i * 16 + fq * 4);
        const u32x2 zz = zzv[i];
        u32x2 w; w.x = pk_bf16(oo[i][0] * rs * gn[0] * fsilu(bflo(zz.x)), oo[i][1] * rs * gn[1] * fsilu(bfhi(zz.x))); w.y = pk_bf16(oo[i][2] * rs * gn[2] * fsilu(bflo(zz.y)), oo[i][3] * rs * gn[3] * fsilu(bfhi(zz.y)));
        *(u32x2*)(P + tok * NP + C_QA + col) = w;
      }
    }
  }
}


#define XB_TMO      128
#define XB_XCNT(j)  (256  + 64 * (j))
#define XB_XSUB(j)  (1280 + 64 * (j))
#define XB_XGEN(j)  (2304 + 64 * (j))
#define XB_TOP      3328
#define XB_TOPGEN   3392
#define XCD_BAR_WORDS 3456
#define XB_SPIN_CAP (1u << 22)
DI unsigned xb_ld(unsigned* p) { return __hip_atomic_load(p, __ATOMIC_RELAXED, __HIP_MEMORY_SCOPE_AGENT); }
DI unsigned xb_add(unsigned* p, unsigned v) { return __hip_atomic_fetch_add(p, v, __ATOMIC_RELAXED, __HIP_MEMORY_SCOPE_AGENT); }
DI unsigned xb_xcc_id() { return (unsigned)__builtin_amdgcn_s_getreg((3 << 11) | 20) & 0xFu; }
#define XB_SPIN(cond, bar) do { unsigned _sp = 0; while (cond) { __builtin_amdgcn_s_sleep(1); \
    if ((++_sp & 255u) == 0u) { if (xb_ld(&(bar)[XB_TMO])) break; if (_sp > XB_SPIN_CAP) { atomicAdd(&(bar)[XB_TMO], 1u); break; } } } } while (0)
struct XcdBarrier { unsigned* bar; unsigned x; volatile LAS unsigned* st; };
DI XcdBarrier xcd_barrier_post(unsigned* bar, volatile LAS unsigned* st) {
  XcdBarrier b; b.bar = bar; b.x = xb_xcc_id(); b.st = st;
  if (threadIdx.x == 0) (void)xb_add(&bar[XB_XCNT(b.x)], 1u);
  return b;
}
DI void xcd_barrier_complete(unsigned* bar, unsigned x, unsigned& nloc, unsigned& nx) {
  const unsigned G = gridDim.x;
  unsigned sum, cnt, mine, sp = 0u;
  for (;;) {
    sum = 0u; cnt = 0u; mine = 0u;
#pragma unroll
    for (unsigned j = 0; j < 16; ++j) { const unsigned c = xb_ld(&bar[XB_XCNT(j)]); sum += c; cnt += (c > 0u) ? 1u : 0u; mine = (j == x) ? c : mine; }
    if (sum == G) break;
    __builtin_amdgcn_s_sleep(1);
    if ((++sp & 255u) == 0u) { if (xb_ld(&bar[XB_TMO])) break; if (sp > XB_SPIN_CAP) { atomicAdd(&bar[XB_TMO], 1u); break; } }
  }
  nloc = mine > 0u ? mine : 1u; nx = cnt > 0u ? cnt : 1u;
}
DI void xcd_barrier(const XcdBarrier& b) {
  asm volatile("s_waitcnt vmcnt(0)" ::: "memory");
  __syncthreads();
  if (threadIdx.x == 0) {
    unsigned* bar = b.bar;
    __builtin_amdgcn_s_waitcnt(0);
    unsigned nloc = b.st[0], nx = b.st[1];
    if (nloc == 0u) { xcd_barrier_complete(bar, b.x, nloc, nx); b.st[0] = nloc; b.st[1] = nx; }
    const unsigned old = xb_add(&bar[XB_XSUB(b.x)], 1u);
    const unsigned gen = old / nloc;
    if (old + 1u == (gen + 1u) * nloc) {
      __builtin_amdgcn_fence(__ATOMIC_RELEASE, "agent");
      asm volatile("s_waitcnt vmcnt(0)" ::: "memory");
      const unsigned og = xb_add(&bar[XB_TOP], 1u);
      const unsigned tg = og / nx;
      if (og + 1u == (tg + 1u) * nx) xb_add(&bar[XB_TOPGEN], 1u);
      else XB_SPIN(xb_ld(&bar[XB_TOPGEN]) == tg, bar);
      __builtin_amdgcn_fence(__ATOMIC_ACQUIRE, "agent");
      xb_add(&bar[XB_XGEN(b.x)], 1u);
      asm volatile("s_waitcnt vmcnt(0)" ::: "memory");
    } else {
      XB_SPIN(xb_ld(&bar[XB_XGEN(b.x)]) == gen, bar);
      __builtin_amdgcn_fence(__ATOMIC_ACQUIRE, "agent");
      asm volatile("s_waitcnt vmcnt(0)" ::: "memory");
    }
  }
  __syncthreads();
}
#ifndef PHM
#define PHM 0xffff
#endif
__global__ void __launch_bounds__(512, 2) fwd_mega(Params p) {
  extern __shared__ __attribute__((aligned(16))) unsigned char lds_raw[];
  LAS unsigned char* lds = (LAS unsigned char*)lds_raw;
  cg::grid_group grid = cg::this_grid();
  if (threadIdx.x < 4) ((LAS unsigned*)(lds + LDS_XB))[threadIdx.x] = 0u;
  __syncthreads();
  const XcdBarrier xbar = xcd_barrier_post((unsigned*)(p.ws + WS_BAR), (volatile LAS unsigned*)(lds + LDS_XB));
  const int G = gridDim.x, bid = blockIdx.x;
  const long gthreads = (long)G * 512;
#define LANEVARS const int tid = opaque_tid(); const int wid = __builtin_amdgcn_readfirstlane(tid >> 6), lane = tid & 63; const long gtid = (long)bid * 512 + tid; (void)wid; (void)lane; (void)gtid
  unsigned char* ws = p.ws;
  bf16_t* P = (bf16_t*)(ws + WS_PROJ); bf16_t* XB = (bf16_t*)(ws + WS_XB);
  bf16_t* WIN = (bf16_t*)(ws + WS_WIN); bf16_t* WG = (bf16_t*)(ws + WS_WG); bf16_t* WBR = (bf16_t*)(ws + WS_WBR); bf16_t* WOUT = (bf16_t*)(ws + WS_WOUT);
  float* ST = (float*)(ws + WS_ST); float* DD = (float*)(ws + WS_DD); float* SSQ = (float*)(ws + WS_SSQ);
  float* ROPE = (float*)(ws + WS_ROPE); float* LB = (float*)(ws + WS_LB);

  {
    LANEVARS;
    for (int r = (bid * 8 + wid) * 2; r < T_TOK; r += G * 16) {
      f32x4 v[2][4];
#pragma unroll
      for (int rr = 0; rr < 2; ++rr)
#pragma unroll
        for (int i = 0; i < 4; ++i) v[rr][i] = *(const f32x4*)(p.x + (size_t)(r + rr) * DM + i * 256 + lane * 4);
#pragma unroll
      for (int rr = 0; rr < 2; ++rr) {
        float ss = 0.f;
#pragma unroll
        for (int i = 0; i < 4; ++i) {
          u32x2 w; w.x = pk_bf16(v[rr][i][0], v[rr][i][1]); w.y = pk_bf16(v[rr][i][2], v[rr][i][3]);
          *(u32x2*)(XB + (size_t)(r + rr) * DM + i * 256 + lane * 4) = w;
          ss += (v[rr][i][0] * v[rr][i][0] + v[rr][i][1] * v[rr][i][1]) + (v[rr][i][2] * v[rr][i][2] + v[rr][i][3] * v[rr][i][3]);
        }
#pragma unroll
        for (int o = 32; o >= 1; o >>= 1) ss += __shfl_xor(ss, o);
        if (lane < 16) SSQ[(size_t)(r + rr) * 16 + lane] = lane == 0 ? ss : 0.f;
      }
    }
    for (long i = gtid; i < (long)SEQ * 32; i += gthreads) {
      const int pos = (int)(i >> 5), j = (int)(i & 31);
      const float invf = powf(10000.0f, -(float)j / 32.0f);
      const float ang = (float)pos * invf;
      double rev = (double)ang * 0.15915494309189535; rev -= floor(rev);
      ROPE[(size_t)pos * 64 + j] = __builtin_amdgcn_cosf((float)rev); ROPE[(size_t)pos * 64 + 32 + j] = __builtin_amdgcn_sinf((float)rev);
    }
    for (long i = gtid; i < 1024; i += gthreads) {
      const float a0 = p.lb_logits[i], a1 = p.lb_logits[1024 + i], a2 = p.lb_logits[2048 + i], a3 = p.lb_logits[3072 + i];
      const float mx = fmaxf(fmaxf(a0, a1), fmaxf(a2, a3));
      const float e0 = expf(a0 - mx), e1 = expf(a1 - mx), e2 = expf(a2 - mx), e3 = expf(a3 - mx); const float inv = 1.0f / (e0 + e1 + e2 + e3);
      LB[i] = 0.f; LB[1024 + i] = e1 * inv; LB[2048 + i] = (e1 + e2) * inv; LB[3072 + i] = (e1 + e2 + e3) * inv;
    }
    convert_w(p.w_in, NIN, DM, WIN, NP, 1, 0, p.norm_gain, gtid, gthreads);
  }
  if (p.use_cg_sync) grid.sync(); else xcd_barrier(xbar);

  for (int l = 0; l < DEPTH; ++l) {
    if (2 * bid >= G) { LANEVARS;
    const long ct = (long)(bid - (G + 1) / 2) * 512 + tid, cth = (long)(G - (G + 1) / 2) * 512;
    convert_w(p.w_in + (size_t)l * DM * NIN, NIN, DM, WG, 3072, 0, NP, p.norm_gain + l * DM, ct, cth);
    convert_w(p.wba + (size_t)l * 512 * DM, DM, 512, WBR, 1024, 0, 0, nullptr, ct, cth);
    convert_w(p.wbb + (size_t)l * 512 * DM, DM, 512, WBR + 1024 * 512, 1024, 0, 0, nullptr, ct, cth);
    convert_w(p.wbc + (size_t)l * 512 * DM, DM, 512, WBR + 2 * 1024 * 512, 1024, 0, 0, nullptr, ct, cth);
    convert_w(p.w_out + (size_t)l * DM * DM, DM, DM, WOUT, 1024, 0, 0, nullptr, ct, cth); }
    if (PHM & 1) {
      GenPlain gen{(const char*)XB, (const char*)WIN, DM * 2, DM * 2, 16, 128, NP / 256, G, bid};
      EpiProj epi{P, SSQ, LB + l * 1024};
      gemm_phase<1>(lds, gen, epi, SSQ);
    }
    xcd_barrier(xbar);
    if (l + 1 < DEPTH) { LANEVARS; convert_w(p.w_in + (size_t)(l + 1) * DM * NIN, NIN, DM, WIN, NP, 1, 0, p.norm_gain + (l + 1) * DM, gtid, gthreads); }
    if (PHM & 2) for (int item = bid; item < 256; item += G) sgu_item(lds, p, l, item);
    if (PHM & 4) for (int item = bid; item < 512; item += G) attn_item(lds, p, l, item);
    if (PHM & 8) for (int item = bid; item < 32 * NSC; item += G) {
      LANEVARS;
      const int seq = item / NSC, n = item % NSC, dir = seq & 1, bh = seq >> 1, b = bh >> 2, h = bh & 3; const int nn = dir ? NSC - 1 - n : n;
      f32x4 S[8];
#pragma unroll
      for (int i = 0; i < 8; ++i) S[i] = (f32x4){0.f, 0.f, 0.f, 0.f};
      float btot = 0.f;
      hgrn_super<false>(lds, p, l, b, h, nn, dir, S, btot);
      float* dst = ST + ((size_t)seq * NSC + n) * 16384;
      const int fr = lane & 15, fq = lane >> 4;
#pragma unroll
      for (int dvt = 0; dvt < 8; ++dvt)
#pragma unroll
        for (int j = 0; j < 4; ++j) dst[(wid * 16 + fq * 4 + j) * 128 + dvt * 16 + fr] = S[dvt][j];
      if (tid < 128) DD[((size_t)seq * NSC + n) * 128 + tid] = __builtin_amdgcn_exp2f(btot);
    }
    xcd_barrier(xbar);
    { LANEVARS;
    for (long e = gtid; e < 32L * 4096; e += gthreads) {
      const int seq = (int)(e >> 12), q4 = (int)(e & 4095); const int dk = q4 >> 5;
      float* base = ST + (size_t)seq * NSC * 16384 + (size_t)q4 * 4; const float* dbase = DD + (size_t)seq * NSC * 128 + dk;
      f32x4 carry = {0.f, 0.f, 0.f, 0.f};
      for (int nb = 0; nb < NSC; nb += 16) {
        f32x4 u[16]; float dc[16];
#pragma unroll
        for (int i = 0; i < 16; ++i) { u[i] = *(const f32x4*)(base + (size_t)(nb + i) * 16384); dc[i] = dbase[(nb + i) * 128]; }
#pragma unroll
        for (int i = 0; i < 16; ++i) { *(f32x4*)(base + (size_t)(nb + i) * 16384) = carry; carry = carry * dc[i] + u[i]; }
      }
    } }
    xcd_barrier(xbar);
    if (PHM & 16) for (int item = bid; item < 16 * NSC; item += G) {
      LANEVARS;
      const int nn = item % NSC, bh = item / NSC, b = bh >> 2, h = bh & 3;
      const int fr = lane & 15, fq = lane >> 4;
      for (int dir = 0; dir < 2; ++dir) {
        const int seq = bh * 2 + dir, n = dir ? NSC - 1 - nn : nn;
        const float* src = ST + ((size_t)seq * NSC + n) * 16384;
        f32x4 S[8];
#pragma unroll
        for (int dvt = 0; dvt < 8; ++dvt)
#pragma unroll
          for (int j = 0; j < 4; ++j) S[dvt][j] = src[(wid * 16 + fq * 4 + j) * 128 + dvt * 16 + fr];
        float btot = 0.f;
        hgrn_super<true>(lds, p, l, b, h, nn, dir, S, btot);
      }
    }
    xcd_barrier(xbar);
    if (PHM & 32) {
      GenMerge gen{(const char*)XB, (const char*)P, (const char*)WG, (const char*)WBR, G, bid};
      EpiMerge epi{P, SSQ, ws + WS_ST + (size_t)bid * 262144};
      gemm_phase<2>(lds, gen, epi, SSQ);
    }
    xcd_barrier(xbar);
    if (PHM & 64) {
      GenPlain gen{(const char*)(P + C_MERGED), (const char*)WOUT, NP * 2, DM * 2, 16, 128, 4, G, bid};
      EpiOut epi{p.x, p.out, XB, SSQ, l == 0 ? 1 : 0, l == DEPTH - 1 ? 1 : 0};
      gemm_phase<0>(lds, gen, epi, SSQ);
    }
    if (l + 1 < DEPTH) xcd_barrier(xbar);
  }
}

extern "C" void kernel_launch(void* const* d_in, const int* in_sizes, int n_in, void* d_out, int out_size,
                              void* d_ws, size_t ws_size, hipStream_t stream) {
  static int grid_blocks = 0;
  if (!grid_blocks) {
    int dev = 0, cus = 0, per_cu = 0;
    (void)hipGetDevice(&dev);
    (void)hipDeviceGetAttribute(&cus, hipDeviceAttributeMultiprocessorCount, dev);
    (void)hipFuncSetAttribute((const void*)fwd_mega, hipFuncAttributeMaxDynamicSharedMemorySize, LDS_BYTES);
    (void)hipOccupancyMaxActiveBlocksPerMultiprocessor(&per_cu, (const void*)fwd_mega, 512, LDS_BYTES);
    (void)hipGetLastError();
    grid_blocks = cus > 0 ? cus : 256;
    if (ws_size < WS_END) { fprintf(stderr, "workspace too small: %zu < %zu\n", ws_size, (size_t)WS_END); grid_blocks = -1; }
  }
  if (grid_blocks < 0) return;
  Params p{};
  p.x = (const float*)d_in[0]; p.w_in = (const float*)d_in[1]; p.norm_gain = (const float*)d_in[2]; p.lb_logits = (const float*)d_in[3];
  p.hg_gain = (const float*)d_in[4]; p.sg_g = (const float*)d_in[5]; p.sg_b = (const float*)d_in[6]; p.w_sp = (const float*)d_in[7];
  p.b_sp = (const float*)d_in[8]; p.qg = (const float*)d_in[9]; p.kg = (const float*)d_in[10]; p.sink = (const float*)d_in[11];
  p.wba = (const float*)d_in[12]; p.wbb = (const float*)d_in[13]; p.wbc = (const float*)d_in[14]; p.w_out = (const float*)d_in[15];
  p.out = (float*)d_out; p.ws = (unsigned char*)d_ws;
  (void)hipMemsetAsync((unsigned char*)d_ws + WS_BAR, 0, 3456 * 4, stream);
  void* args[] = {&p};
  hipError_t e = hipLaunchCooperativeKernel((const void*)fwd_mega, dim3(grid_blocks), dim3(512), args, LDS_BYTES, stream);
  if (e != hipSuccess) fprintf(stderr, "cooperative launch failed: %s (grid %d)\n", hipGetErrorString(e), grid_blocks);
}
```

```cpp
#include <hip/hip_runtime.h>
#include <hip/hip_cooperative_groups.h>
#include <cstdio>
namespace cg = cooperative_groups;

#define LAS __attribute__((address_space(3)))
#define DI __device__ __forceinline__
typedef unsigned short bf16_t;
typedef short bf16x8 __attribute__((ext_vector_type(8)));
typedef short bf16x4 __attribute__((ext_vector_type(4)));
typedef float f32x4 __attribute__((ext_vector_type(4)));
typedef float f32x2 __attribute__((ext_vector_type(2)));
typedef unsigned u32x4 __attribute__((ext_vector_type(4)));
typedef unsigned u32x2 __attribute__((ext_vector_type(2)));
typedef __bf16 bfv2 __attribute__((ext_vector_type(2)));

constexpr int T_TOK = 32768, SEQ = 8192, DM = 1024, DEPTH = 4;
constexpr int NP = 5376;
constexpr int NIN = 8448;
constexpr float EPS = 1e-6f;
constexpr int C_QA = 0, C_IA = 512, C_LFF = 1024, C_LFB = 1536, C_ZA = 2048, C_UB = 2560, C_ZB = 3072, C_VB = 3584,
              C_QC = 4096, C_ZC = 4608, C_KC = 5120, C_VC = 5248;
constexpr int C_MERGED = 1024;
constexpr int C_GSCR = 3072;

constexpr size_t WS_PROJ = 0;
constexpr size_t WS_XB   = WS_PROJ + (size_t)T_TOK * NP * 2;
constexpr size_t WS_WIN  = WS_XB + (size_t)T_TOK * DM * 2;
constexpr size_t WS_WG   = WS_WIN + (size_t)NP * DM * 2;
constexpr size_t WS_WBR  = WS_WG + (size_t)3072 * DM * 2;
constexpr size_t WS_WOUT = WS_WBR + (size_t)3 * 1024 * 512 * 2;
constexpr size_t WS_ST   = WS_WOUT + (size_t)1024 * 1024 * 2;
constexpr size_t WS_DD   = WS_ST + (size_t)32 * 32 * 16384 * 4;
constexpr size_t WS_SSQ  = WS_DD + (size_t)32 * 32 * 128 * 4;
constexpr size_t WS_ROPE = WS_SSQ + (size_t)16 * T_TOK * 4;
constexpr size_t WS_LB   = WS_ROPE + (size_t)SEQ * 64 * 4;
constexpr size_t WS_BAR  = WS_LB + (size_t)DEPTH * 1024 * 4;
constexpr size_t WS_END  = WS_BAR + (size_t)3456 * 4;

constexpr int LDS_BYTES = 148 * 1024;
constexpr int LDS_RSB = 128 * 1024;
constexpr int LDS_XB = LDS_BYTES - 16;

struct Params {
  const float* x; const float* w_in; const float* norm_gain; const float* lb_logits; const float* hg_gain;
  const float* sg_g; const float* sg_b; const float* w_sp; const float* b_sp; const float* qg; const float* kg;
  const float* sink; const float* wba; const float* wbb; const float* wbc; const float* w_out;
  float* out; unsigned char* ws;
  int use_cg_sync; int pad0;
};

DI unsigned pk_bf16(float lo, float hi) { f32x2 v = {lo, hi}; bfv2 b = __builtin_convertvector(v, bfv2); return __builtin_bit_cast(unsigned, b); }
DI bf16_t f2bf(float f) { return (bf16_t)(pk_bf16(f, 0.f) & 0xffffu); }
DI float bf2f(unsigned short b) { return __uint_as_float(((unsigned)b) << 16); }
DI float bflo(unsigned w) { return __uint_as_float(w << 16); }
DI float bfhi(unsigned w) { return __uint_as_float(w & 0xffff0000u); }
DI unsigned short f2h(float f) { _Float16 h = (_Float16)f; return __builtin_bit_cast(unsigned short, h); }
DI float h2f(unsigned short u) { _Float16 h = __builtin_bit_cast(_Float16, u); return (float)h; }
DI float fsigmoid(float v) { return __builtin_amdgcn_rcpf(1.0f + __builtin_amdgcn_exp2f(v * -1.4426950408889634f)); }
DI float fsilu(float v) { return v * __builtin_amdgcn_rcpf(1.0f + __builtin_amdgcn_exp2f(v * -1.4426950408889634f)); }
DI float fgelu(float v) { return v * __builtin_amdgcn_rcpf(1.0f + __builtin_amdgcn_exp2f(v * (-2.3022082f - 0.1029432f * v * v))); }
DI float row_rs(const float* ssqp, int r, int fq) {
  const f32x4 a = *(const f32x4*)(ssqp + (size_t)r * 16 + fq * 4);
  float t = (a[0] + a[1]) + (a[2] + a[3]);
  t += __shfl_xor(t, 16); t += __shfl_xor(t, 32);
  return rsqrtf(t * (1.0f / 1024.0f) + EPS); }
DI float row_rs_lds(const LAS unsigned char* lds, int rl, int fq) {
  const f32x4 a = *(const LAS f32x4*)(lds + LDS_RSB + rl * 64 + fq * 16);
  float t = (a[0] + a[1]) + (a[2] + a[3]);
  t += __shfl_xor(t, 16); t += __shfl_xor(t, 32);
  return rsqrtf(t * (1.0f / 1024.0f) + EPS); }
DI f32x4 mfma16(bf16x8 a, bf16x8 b, f32x4 c) { return __builtin_amdgcn_mfma_f32_16x16x32_bf16(a, b, c, 0, 0, 0); }

DI void lds_barrier() { asm volatile("s_waitcnt lgkmcnt(0)" ::: "memory"); __builtin_amdgcn_s_barrier(); asm volatile("" ::: "memory"); }
DI int opaque_tid() { int t = threadIdx.x; asm volatile("" : "+v"(t)); return t; }
constexpr int BM = 256, BK = 64, HALF = 128, HTB = HALF * BK * 2, NXCD = 8, WGM = 8;
DI int lds_byte(int r, int c) { const int st = (r >> 4) * 2 + (c >> 5), rr = r & 15, cc = c & 31, ob = rr * 64 + cc * 2; return st * 1024 + (ob ^ (((ob >> 9) & 1) << 5)); }
DI void stage_rc(int b, int& R, int& C) { const int st = b / 1024, sb = b % 1024, swz = sb ^ (((sb >> 9) & 1) << 5); R = (st >> 1) * 16 + swz / 64; C = (st & 1) * 32 + (swz % 64) / 2; }
DI int perm32(int rho) { const int n = rho >> 4, i = rho & 15; return 8 * (i >> 2) + 4 * n + (i & 3); }

struct GUnit { const char* A; const char* B; int lda2, ldb2, nt, pm, pn, mode; };

DI void tile_order(int L, int nM, int nN, int& pm, int& pn) {
  const int nwg = nM * nN; int wgid = L;
  { const int q = nwg / NXCD, r = nwg % NXCD, xcd = wgid % NXCD, off = wgid / NXCD; wgid = (xcd < r ? xcd * (q + 1) : r * (q + 1) + (xcd - r) * q) + off; }
  const int nig = WGM * nN, gid = wgid / nig, fm = gid * WGM, gsz = (nM - fm) < WGM ? (nM - fm) : WGM;
  pm = fm + ((wgid % nig) % gsz); pn = (wgid % nig) / gsz;
}

template <int RSMODE  , class Gen, class Epi>
DI void gemm_phase(LAS unsigned char* lds, const Gen& gen, const Epi& E, const float* ssqg) {
  const int tid = opaque_tid(), wid = __builtin_amdgcn_readfirstlane(tid >> 6), lane = tid & 63, wr = wid >> 2, wc = wid & 3, fr = lane & 15, fq = lane >> 4;
  int RA[2], RB[2], CC[2];
#pragma unroll
  for (int i = 0; i < 2; ++i) { int R, C; stage_rc(tid * 16 + i * 8192, R, C); RA[i] = R; RB[i] = (R & ~31) + perm32(R & 31); CC[i] = C * 2; }
  const unsigned ldsw = (unsigned)wid * 1024u;
  const int aoff = lds_byte(wr * 64 + fr, fq * 8), boff = lds_byte(wc * 32 + fr, fq * 8);
#define G_SA(b, h) (((b) * 2 + (h)) * HTB)
#define G_SB(b, h) ((4 + (b) * 2 + (h)) * HTB)
#define G_STAGEA(bufoff, gbase, ld2) do { _Pragma("unroll") for (int _i = 0; _i < 2; ++_i) \
    __builtin_amdgcn_global_load_lds((const unsigned*)((gbase) + (unsigned)(RA[_i] * (ld2) + CC[_i])), (LAS unsigned*)(lds + (bufoff) + ldsw + _i * 8192), 16, 0, 0); } while (0)
#define G_STAGEB(bufoff, gbase, ld2) do { _Pragma("unroll") for (int _i = 0; _i < 2; ++_i) \
    __builtin_amdgcn_global_load_lds((const unsigned*)((gbase) + (unsigned)(RB[_i] * (ld2) + CC[_i])), (LAS unsigned*)(lds + (bufoff) + ldsw + _i * 8192), 16, 0, 0); } while (0)
#define G_LDA(dst, b, h) do { _Pragma("unroll") for (int m = 0; m < 4; ++m) _Pragma("unroll") for (int k = 0; k < 2; ++k) dst[m][k] = *(const LAS bf16x8*)(lds + G_SA(b, h) + aoff + m * 2048 + k * 1024); } while (0)
#define G_LDB(dst, b, h) do { _Pragma("unroll") for (int n = 0; n < 2; ++n) _Pragma("unroll") for (int k = 0; k < 2; ++k) dst[n][k] = *(const LAS bf16x8*)(lds + G_SB(b, h) + boff + n * 2048 + k * 1024); } while (0)
#define G_MMA(ai, bj, At, Bt) do { __builtin_amdgcn_s_setprio(1); _Pragma("unroll") for (int m = 0; m < 4; ++m) _Pragma("unroll") for (int n = 0; n < 2; ++n) _Pragma("unroll") for (int k = 0; k < 2; ++k) \
    acc[ai][bj][m][n] = __builtin_amdgcn_mfma_f32_16x16x32_bf16(Bt[n][k], At[m][k], acc[ai][bj][m][n], 0, 0, 0); __builtin_amdgcn_s_setprio(0); } while (0)
#define G_WAIT_V(n) asm volatile("s_waitcnt vmcnt(" #n ")" ::: "memory")
#define G_WAIT_L(n) asm volatile("s_waitcnt lgkmcnt(" #n ")" ::: "memory")
#define G_BAR __builtin_amdgcn_s_barrier()
#define G_SCHED __builtin_amdgcn_sched_barrier(0)
  GUnit cur, nxt; int ui = 0;
  if (!gen.get(0, cur)) return;
  f32x4 acc[2][2][4][2];
#pragma unroll
  for (int a = 0; a < 2; ++a)
#pragma unroll
    for (int b = 0; b < 2; ++b)
#pragma unroll
      for (int m = 0; m < 4; ++m)
#pragma unroll
        for (int n = 0; n < 2; ++n) acc[a][b][m][n] = (f32x4){0.f, 0.f, 0.f, 0.f};
  bf16x8 At[4][2], B0[2][2], B1[2][2];
  const char* cA = cur.A; const char* cB = cur.B; int clda = cur.lda2, cldb = cur.ldb2;
  constexpr size_t kstep = BK * 2;
  G_STAGEB(G_SB(0, 0), cB, cldb); G_STAGEA(G_SA(0, 0), cA, clda); G_STAGEB(G_SB(0, 1), cB + (size_t)HALF * cldb, cldb); G_STAGEA(G_SA(0, 1), cA + (size_t)HALF * clda, clda);
  if (wr == 1) G_BAR;
  G_WAIT_V(4); G_BAR;
  G_STAGEB(G_SB(1, 0), cB + kstep, cldb); G_STAGEA(G_SA(1, 0), cA + kstep, clda); G_STAGEB(G_SB(1, 1), cB + (size_t)HALF * cldb + kstep, cldb);
  G_WAIT_V(6); G_BAR;
  for (;;) {
    const bool has_next = gen.get(ui + 1, nxt);
    const char* nA = has_next ? nxt.A : cA; const char* nB = has_next ? nxt.B : cB;
    const int nlda = has_next ? nxt.lda2 : clda, nldb = has_next ? nxt.ldb2 : cldb;
    const int nt = cur.nt;
    for (int t = 0; t < nt; t += 2) {
      const bool last = (t == nt - 2);
      const char* a1 = cA + (size_t)(t + 1) * kstep;
      const char* a2 = last ? nA : cA + (size_t)(t + 2) * kstep; const char* b2 = last ? nB : cB + (size_t)(t + 2) * kstep;
      const int lda_n = last ? nlda : clda, ldb_n = last ? nldb : cldb;
      const char* a3 = a2 + kstep; const char* b3 = b2 + kstep;
      G_LDB(B0, 0, 0); G_SCHED; G_LDA(At, 0, 0); G_STAGEA(G_SA(1, 1), a1 + (size_t)HALF * clda, clda);
      if (RSMODE != 0 && t == 2 && (RSMODE == 1 || cur.mode == 0)) {
        const char* rsrc = (const char*)ssqg + (size_t)cur.pm * (BM * 64) + ldsw + (unsigned)lane * 16u;
#pragma unroll
        for (int _i = 0; _i < 2; ++_i) __builtin_amdgcn_global_load_lds((const unsigned*)(rsrc + _i * 8192), (LAS unsigned*)(lds + LDS_RSB + ldsw + _i * 8192), 16, 0, 0);
      }
      G_WAIT_L(8); G_BAR; G_WAIT_L(0); G_MMA(0, 0, At, B0); G_BAR; G_SCHED;
      G_LDB(B1, 0, 1); G_STAGEB(G_SB(0, 0), b2, ldb_n);
      G_BAR; G_WAIT_L(0); G_MMA(0, 1, At, B1); G_BAR;
      G_LDA(At, 0, 1); G_STAGEA(G_SA(0, 0), a2, lda_n);
      G_BAR; G_WAIT_L(0); G_MMA(1, 0, At, B0); G_BAR; G_SCHED;
      G_STAGEB(G_SB(0, 1), b2 + (size_t)HALF * ldb_n, ldb_n);
      G_WAIT_V(6); G_BAR; G_MMA(1, 1, At, B1); G_BAR;
      G_LDB(B0, 1, 0); G_SCHED; G_LDA(At, 1, 0); G_STAGEA(G_SA(0, 1), a2 + (size_t)HALF * lda_n, lda_n);
      G_WAIT_L(8); G_BAR; G_WAIT_L(0); G_MMA(0, 0, At, B0); G_BAR; G_SCHED;
      G_LDB(B1, 1, 1); G_STAGEB(G_SB(1, 0), b3, ldb_n);
      G_BAR; G_WAIT_L(0); G_MMA(0, 1, At, B1); G_BAR;
      G_LDA(At, 1, 1); G_STAGEA(G_SA(1, 0), a3, lda_n);
      G_BAR; G_WAIT_L(0); G_MMA(1, 0, At, B0); G_BAR; G_SCHED;
      G_STAGEB(G_SB(1, 1), b3 + (size_t)HALF * ldb_n, ldb_n);
      G_WAIT_V(6); G_BAR; G_MMA(1, 1, At, B1); G_BAR;
    }
    E(acc, cur, wr, wc, fr, fq, lds);
    if (!has_next) break;
#pragma unroll
    for (int a = 0; a < 2; ++a)
#pragma unroll
      for (int b = 0; b < 2; ++b)
#pragma unroll
        for (int m = 0; m < 4; ++m)
#pragma unroll
          for (int n = 0; n < 2; ++n) acc[a][b][m][n] = (f32x4){0.f, 0.f, 0.f, 0.f};
    cur = nxt; cA = nA; cB = nB; clda = nlda; cldb = nldb; ++ui;
  }
  G_WAIT_V(0);
  if (wr == 0) G_BAR;
  G_BAR;
#undef G_SA
#undef G_SB
#undef G_STAGEA
#undef G_STAGEB
#undef G_LDA
#undef G_LDB
#undef G_MMA
}

struct GenPlain {
  const char* A; const char* B; int lda2, ldb2, nt, nM, nN, G, c;
  DI bool get(int i, GUnit& u) const {
    const long L = (long)i * G + c; if (L >= (long)nM * nN) return false;
    int pm, pn; tile_order((int)L, nM, nN, pm, pn);
    u.A = A + (size_t)pm * BM * lda2; u.B = B + (size_t)pn * BM * ldb2; u.lda2 = lda2; u.ldb2 = ldb2; u.nt = nt; u.pm = pm; u.pn = pn; u.mode = 0; return true;
  }
};
struct GenMerge {
  const char* xb; const char* proj; const char* wg; const char* wbr; int G, c;
  DI bool get(int i, GUnit& u) const {
    const int ti = i / 6, sub = i - ti * 6, br = sub >> 1;
    const long L = (long)ti * G + c; if (L >= 512) return false;
    int pm, pn; tile_order((int)L, 128, 4, pm, pn);
    u.pm = pm; u.pn = pn;
    if ((sub & 1) == 0) { u.A = xb + (size_t)pm * BM * 2048; u.lda2 = 2048; u.B = wg + ((size_t)br * 1024 + (size_t)pn * BM) * 2048; u.ldb2 = 2048; u.nt = 16; u.mode = 0; }
    else { const int col = br == 0 ? C_QA : (br == 1 ? C_UB : C_QC);
      u.A = proj + (size_t)pm * BM * (NP * 2) + (size_t)col * 2; u.lda2 = NP * 2; u.B = wbr + ((size_t)br * 1024 + (size_t)pn * BM) * 1024; u.ldb2 = 1024; u.nt = 8; u.mode = br + 1; }
    return true;
  }
};

struct EpiProj {
  bf16_t* P; const float* ssq; const float* lb;
  DI void operator()(const f32x4 (&acc)[2][2][4][2], const GUnit& u, int wr, int wc, int fr, int fq, const LAS unsigned char* lds) const {
    const int row0 = u.pm * BM + wr * 64 + fr;
    float rs[2][4];
#pragma unroll
    for (int ai = 0; ai < 2; ++ai)
#pragma unroll
      for (int m = 0; m < 4; ++m) rs[ai][m] = row_rs_lds(lds, wr * 64 + fr + ai * HALF + m * 16, fq);
#pragma unroll
    for (int bj = 0; bj < 2; ++bj) {
      const int cb = u.pn * BM + bj * HALF; const int region = cb >> 9;
      const int col0 = cb + wc * 32 + 8 * fq;
      int act = 0;
      if (region == 2 || region == 3) act = 3;
      float lbv[8];
      if (act == 3) { const f32x4 l0 = *(const f32x4*)(lb + col0 - 1024), l1 = *(const f32x4*)(lb + col0 - 1024 + 4);
#pragma unroll
        for (int j = 0; j < 4; ++j) { lbv[j] = l0[j]; lbv[4 + j] = l1[j]; } }
#pragma unroll
      for (int ai = 0; ai < 2; ++ai)
#pragma unroll
        for (int m = 0; m < 4; ++m) {
          float v[8];
#pragma unroll
          for (int j = 0; j < 4; ++j) { v[j] = acc[ai][bj][m][0][j] * rs[ai][m]; v[4 + j] = acc[ai][bj][m][1][j] * rs[ai][m]; }
          u32x4 w;
          if (act == 3) {
            unsigned short hh[8];
#pragma unroll
            for (int j = 0; j < 8; ++j) { const float f = lbv[j] + (1.0f - lbv[j]) * fsigmoid(v[j]); hh[j] = f2h(fmaxf(__builtin_amdgcn_logf(f), -43.0f)); }
            w.x = hh[0] | ((unsigned)hh[1] << 16); w.y = hh[2] | ((unsigned)hh[3] << 16); w.z = hh[4] | ((unsigned)hh[5] << 16); w.w = hh[6] | ((unsigned)hh[7] << 16);
          } else {
            if (act == 1) {
#pragma unroll
              for (int j = 0; j < 8; ++j) v[j] = fsilu(v[j]);
            } else if (act == 2) {
#pragma unroll
              for (int j = 0; j < 8; ++j) v[j] = fgelu(v[j]);
            }
            w.x = pk_bf16(v[0], v[1]); w.y = pk_bf16(v[2], v[3]); w.z = pk_bf16(v[4], v[5]); w.w = pk_bf16(v[6], v[7]);
          }
          *(u32x4*)(P + (size_t)(row0 + ai * HALF + m * 16) * NP + col0) = w;
          asm volatile("" ::: "memory");
        }
    }
  }
};
struct EpiMerge {
  bf16_t* P; const float* ssq; unsigned char* scr;
  template <int MODE>
  DI void run(const f32x4 (&acc)[2][2][4][2], const GUnit& u, int wr, int wc, int fr, int fq, const LAS unsigned char* lds) const {
    const int row0 = u.pm * BM + wr * 64 + fr;
    unsigned voff = (unsigned)((wr * 4 + wc) * 64 + fq * 16 + fr) * 8u; asm volatile("" : "+v"(voff));
#pragma unroll
    for (int ai = 0; ai < 2; ++ai) {
      u32x2 g[4][2]; u32x4 mm[4][2];
      if (MODE >= 1) {
#pragma unroll
        for (int m = 0; m < 4; ++m)
#pragma unroll
          for (int bj = 0; bj < 2; ++bj) { const int q = (ai * 4 + m) * 2 + bj;
            g[m][bj] = *(const u32x2*)((scr + 131072 + q * 4096) + voff);
            if (MODE >= 2) mm[m][bj] = *(const u32x4*)((scr + q * 8192) + voff * 2u); }
      }
#pragma unroll
      for (int m = 0; m < 4; ++m) {
        const int r = row0 + ai * HALF + m * 16;
        float rsv = 0.f; if (MODE == 0) rsv = row_rs_lds(lds, wr * 64 + fr + ai * HALF + m * 16, fq) * -1.4426950408889634f;
#pragma unroll
        for (int bj = 0; bj < 2; ++bj) {
          const int q = (ai * 4 + m) * 2 + bj;
          u32x2* gp = (u32x2*)((scr + 131072 + q * 4096) + voff); u32x4* mp = (u32x4*)((scr + q * 8192) + voff * 2u);
          if (MODE == 0) {
            u32x2 w = {0u, 0u};
#pragma unroll
            for (int j = 0; j < 4; ++j) {
              w.x |= (unsigned)__float2uint_rn(__builtin_amdgcn_rcpf(__builtin_fmaf(__builtin_amdgcn_exp2f(acc[ai][bj][m][0][j] * rsv), 1.0f / 255.0f, 1.0f / 255.0f))) << (8 * j);
              w.y |= (unsigned)__float2uint_rn(__builtin_amdgcn_rcpf(__builtin_fmaf(__builtin_amdgcn_exp2f(acc[ai][bj][m][1][j] * rsv), 1.0f / 255.0f, 1.0f / 255.0f))) << (8 * j); }
            *gp = w;
          } else {
            const u32x2 gg = g[m][bj];
            float v[8];
#pragma unroll
            for (int j = 0; j < 4; ++j) { v[j] = acc[ai][bj][m][0][j] * ((float)((gg.x >> (8 * j)) & 0xffu) * (1.0f / 255.0f)); v[4 + j] = acc[ai][bj][m][1][j] * ((float)((gg.y >> (8 * j)) & 0xffu) * (1.0f / 255.0f)); }
            if (MODE >= 2) { const u32x4 mv = mm[m][bj];
              v[0] += bflo(mv.x); v[1] += bfhi(mv.x); v[2] += bflo(mv.y); v[3] += bfhi(mv.y); v[4] += bflo(mv.z); v[5] += bfhi(mv.z); v[6] += bflo(mv.w); v[7] += bfhi(mv.w); }
            u32x4 w; w.x = pk_bf16(v[0], v[1]); w.y = pk_bf16(v[2], v[3]); w.z = pk_bf16(v[4], v[5]); w.w = pk_bf16(v[6], v[7]);
            if (MODE == 3) *(u32x4*)(P + (size_t)r * NP + C_MERGED + u.pn * BM + bj * HALF + wc * 32 + 8 * fq) = w;
            else *mp = w;
          }
        }
      }
      asm volatile("" ::: "memory");
    }
  }
  DI void operator()(const f32x4 (&acc)[2][2][4][2], const GUnit& u, int wr, int wc, int fr, int fq, const LAS unsigned char* lds) const {
    if (u.mode == 0) run<0>(acc, u, wr, wc, fr, fq, lds); else if (u.mode == 1) run<1>(acc, u, wr, wc, fr, fq, lds); else if (u.mode == 2) run<2>(acc, u, wr, wc, fr, fq, lds); else run<3>(acc, u, wr, wc, fr, fq, lds);
  }
};
struct EpiOut {
  const float* XI; float* XO; bf16_t* XB; float* ssqn; int first, lastl;
  DI void operator()(const f32x4 (&acc)[2][2][4][2], const GUnit& u, int wr, int wc, int fr, int fq, const LAS unsigned char*) const {
    const int row0 = u.pm * BM + wr * 64 + fr;
#pragma unroll
    for (int ai = 0; ai < 2; ++ai)
#pragma unroll
      for (int mh = 0; mh < 2; ++mh) {
        f32x4 xa[2][2], xb2[2][2];
        if (first) {
#pragma unroll
          for (int mm = 0; mm < 2; ++mm)
#pragma unroll
            for (int bj = 0; bj < 2; ++bj) { const float* xi = XI + (size_t)(row0 + ai * HALF + (mh * 2 + mm) * 16) * DM + u.pn * BM + bj * HALF + wc * 32 + 8 * fq; xa[mm][bj] = *(const f32x4*)xi; xb2[mm][bj] = *(const f32x4*)(xi + 4); }
        } else {
          u32x4 xw[2][2];
#pragma unroll
          for (int mm = 0; mm < 2; ++mm)
#pragma unroll
            for (int bj = 0; bj < 2; ++bj) xw[mm][bj] = *(const u32x4*)(XB + (size_t)(row0 + ai * HALF + (mh * 2 + mm) * 16) * DM + u.pn * BM + bj * HALF + wc * 32 + 8 * fq);
#pragma unroll
          for (int mm = 0; mm < 2; ++mm)
#pragma unroll
            for (int bj = 0; bj < 2; ++bj) { xa[mm][bj] = (f32x4){bflo(xw[mm][bj].x), bfhi(xw[mm][bj].x), bflo(xw[mm][bj].y), bfhi(xw[mm][bj].y)}; xb2[mm][bj] = (f32x4){bflo(xw[mm][bj].z), bfhi(xw[mm][bj].z), bflo(xw[mm][bj].w), bfhi(xw[mm][bj].w)}; }
        }
#pragma unroll
        for (int mm = 0; mm < 2; ++mm) {
          const int m = mh * 2 + mm;
          const int r = row0 + ai * HALF + m * 16; float ss = 0.f;
#pragma unroll
          for (int bj = 0; bj < 2; ++bj) {
            const int col0 = u.pn * BM + bj * HALF + wc * 32 + 8 * fq;
            f32x4 x0 = xa[mm][bj] + acc[ai][bj][m][0], x1 = xb2[mm][bj] + acc[ai][bj][m][1];
            if (lastl) { float* xp = XO + (size_t)r * DM + col0; *(f32x4*)xp = x0; *(f32x4*)(xp + 4) = x1; }
            else {
              u32x4 w; w.x = pk_bf16(x0[0], x0[1]); w.y = pk_bf16(x0[2], x0[3]); w.z = pk_bf16(x1[0], x1[1]); w.w = pk_bf16(x1[2], x1[3]);
              *(u32x4*)(XB + (size_t)r * DM + col0) = w;
              ss += (x0[0] * x0[0] + x0[1] * x0[1]) + (x0[2] * x0[2] + x0[3] * x0[3]) + (x1[0] * x1[0] + x1[1] * x1[1]) + (x1[2] * x1[2] + x1[3] * x1[3]);
            }
          }
          if (!lastl) { ss += __shfl_xor(ss, 16); ss += __shfl_xor(ss, 32);
            if (fq == 0) ssqn[(size_t)r * 16 + u.pn * 4 + wc] = ss; }
        }
        asm volatile("" ::: "memory");
      }
  }
};

DI int inproj_orig_col(int n) {
  const int mb = n >> 7, w = n & 127; int ob;
  if (mb < 4) ob = mb; else if (mb < 8) ob = mb + 8; else if (mb < 16) ob = mb - 4; else if (mb < 24) ob = mb;
  else if (mb < 28) ob = mb + 4; else if (mb < 32) ob = mb - 4; else if (mb < 36) ob = mb; else if (mb < 40) ob = mb + 2; else ob = mb - 4;
  return ob * 128 + w;
}
DI void convert_w(const float* W, int ldw, int K, bf16_t* Wt, int Nn, int mapmode, int colbase, const float* gain, long gtid, long gthreads) {
  const long ntask = (long)Nn * (K / 8);
  for (long task0 = gtid; task0 < ntask; task0 += 2 * gthreads) {
    float v[2][8]; int k8s[2], ns[2]; bool ok[2];
#pragma unroll
    for (int u = 0; u < 2; ++u) {
      const long task = task0 + u * gthreads; ok[u] = task < ntask; const long tk = ok[u] ? task : task0;
      const int k8 = (int)(tk / Nn), n = (int)(tk - (long)k8 * Nn); k8s[u] = k8; ns[u] = n;
      const int oc = mapmode ? inproj_orig_col(n) : colbase + n;
#pragma unroll
      for (int i = 0; i < 8; ++i) v[u][i] = W[(size_t)(k8 * 8 + i) * ldw + oc];
    }
#pragma unroll
    for (int u = 0; u < 2; ++u) {
      const int k8 = k8s[u], n = ns[u];
      if (gain) { const f32x4 g0 = *(const f32x4*)(gain + k8 * 8), g1 = *(const f32x4*)(gain + k8 * 8 + 4);
#pragma unroll
        for (int i = 0; i < 4; ++i) { v[u][i] *= g0[i]; v[u][4 + i] *= g1[i]; } }
      u32x4 w; w.x = pk_bf16(v[u][0], v[u][1]); w.y = pk_bf16(v[u][2], v[u][3]); w.z = pk_bf16(v[u][4], v[u][5]); w.w = pk_bf16(v[u][6], v[u][7]);
      if (ok[u]) *(u32x4*)(Wt + (size_t)n * K + k8 * 8) = w;
    }
  }
}

typedef short s16x4 __attribute__((ext_vector_type(4)));
DI bf16x8 tr_pair(const LAS bf16_t* p0, const LAS bf16_t* p1) {
  const s16x4 a = __builtin_amdgcn_ds_read_tr16_b64_v4i16((LAS s16x4*)p0), b = __builtin_amdgcn_ds_read_tr16_b64_v4i16((LAS s16x4*)p1);
  return (bf16x8){a[0], a[1], a[2], a[3], b[0], b[1], b[2], b[3]};
}
constexpr int SG_LD = 528;
DI void sgu_item(LAS unsigned char* lds, const Params& p, int l, int item) {
  bf16_t* P = (bf16_t*)(p.ws + WS_PROJ);
  const int tid = opaque_tid(), wid = __builtin_amdgcn_readfirstlane(tid >> 6), lane = tid & 63, fr = lane & 15, fq = lane >> 4;
  const size_t tok0 = (size_t)item * 128;
  LAS bf16_t* vn = (LAS bf16_t*)lds;
  __syncthreads();
  {
    const float* lng = p.sg_g + l * 512 + lane * 8; const float* lnb = p.sg_b + l * 512 + lane * 8;
    const f32x4 g0 = *(const f32x4*)lng, g1 = *(const f32x4*)(lng + 4), b0 = *(const f32x4*)lnb, b1 = *(const f32x4*)(lnb + 4);
    u32x4 w[16];
#pragma unroll
    for (int i = 0; i < 16; ++i) w[i] = *(const u32x4*)(P + (tok0 + wid * 16 + i) * NP + C_VB + lane * 8);
#pragma unroll
    for (int i = 0; i < 16; ++i) {
      float v[8] = {fgelu(bflo(w[i].x)), fgelu(bfhi(w[i].x)), fgelu(bflo(w[i].y)), fgelu(bfhi(w[i].y)), fgelu(bflo(w[i].z)), fgelu(bfhi(w[i].z)), fgelu(bflo(w[i].w)), fgelu(bfhi(w[i].w))};
      float sm = 0.f;
#pragma unroll
      for (int j = 0; j < 8; ++j) sm += v[j];
#pragma unroll
      for (int o = 32; o >= 1; o >>= 1) sm += __shfl_xor(sm, o);
      const float mu = sm * (1.0f / 512.0f); float q = 0.f;
#pragma unroll
      for (int j = 0; j < 8; ++j) { v[j] -= mu; q += v[j] * v[j]; }
#pragma unroll
      for (int o = 32; o >= 1; o >>= 1) q += __shfl_xor(q, o);
      const float rstd = rsqrtf(q * (1.0f / 512.0f) + EPS);
      u32x4 r;
      r.x = pk_bf16(v[0] * rstd * g0[0] + b0[0], v[1] * rstd * g0[1] + b0[1]); r.y = pk_bf16(v[2] * rstd * g0[2] + b0[2], v[3] * rstd * g0[3] + b0[3]);
      r.z = pk_bf16(v[4] * rstd * g1[0] + b1[0], v[5] * rstd * g1[1] + b1[1]); r.w = pk_bf16(v[6] * rstd * g1[2] + b1[2], v[7] * rstd * g1[3] + b1[3]);
      *(LAS u32x4*)(vn + (wid * 16 + i) * SG_LD + lane * 8) = r;
    }
  }
  __syncthreads();
  const int t = wid * 16 + fr;
#pragma unroll 1
  for (int g = 0; g < 4; ++g) {
    const float* wrow = p.w_sp + (((size_t)l * 4 + g) * 128 + t) * 128;
    bf16x8 bfrag[4];
    f32x4 wa[4], wb[4];
#pragma unroll
    for (int kk = 0; kk < 4; ++kk) { wa[kk] = *(const f32x4*)(wrow + kk * 32 + fq * 4); wb[kk] = *(const f32x4*)(wrow + kk * 32 + 16 + fq * 4); }
    const float bias = p.b_sp[((size_t)l * 4 + g) * 128 + t];
    u32x2 uu[8], zz[8];
#pragma unroll
    for (int ct = 0; ct < 8; ++ct) { const size_t off = (tok0 + t) * NP + g * 128 + ct * 16 + fq * 4; uu[ct] = *(const u32x2*)(P + off + C_UB); zz[ct] = *(const u32x2*)(P + off + C_ZB); }
    asm volatile("" ::: "memory");
#pragma unroll
    for (int kk = 0; kk < 4; ++kk) { u32x4 w; w.x = pk_bf16(wa[kk][0], wa[kk][1]); w.y = pk_bf16(wa[kk][2], wa[kk][3]); w.z = pk_bf16(wb[kk][0], wb[kk][1]); w.w = pk_bf16(wb[kk][2], wb[kk][3]); bfrag[kk] = __builtin_bit_cast(bf16x8, w); }
#pragma unroll
    for (int ct = 0; ct < 8; ++ct) {
      f32x4 acc = {0.f, 0.f, 0.f, 0.f};
#pragma unroll
      for (int kk = 0; kk < 4; ++kk) {
        const LAS bf16_t* base = vn + (kk * 32 + fq * 4 + (fr >> 2)) * SG_LD + g * 128 + ct * 16 + (fr & 3) * 4;
        const bf16x8 a = tr_pair(base, base + 16 * SG_LD);
        acc = mfma16(a, bfrag[kk], acc);
      }
      const size_t off = (tok0 + t) * NP + g * 128 + ct * 16 + fq * 4;
      const float o0 = fgelu(bflo(uu[ct].x)) * (acc[0] + bias) * fsilu(bflo(zz[ct].x)), o1 = fgelu(bfhi(uu[ct].x)) * (acc[1] + bias) * fsilu(bfhi(zz[ct].x));
      const float o2 = fgelu(bflo(uu[ct].y)) * (acc[2] + bias) * fsilu(bflo(zz[ct].y)), o3 = fgelu(bfhi(uu[ct].y)) * (acc[3] + bias) * fsilu(bfhi(zz[ct].y));
      u32x2 w; w.x = pk_bf16(o0, o1); w.y = pk_bf16(o2, o3);
      *(u32x2*)(P + off + C_UB) = w;
    }
  }
  __syncthreads();
}

constexpr int AT_KLD = 80;
constexpr int AT_VLD = 80;
DI void rope8(const float (&x1)[8], const float (&x2)[8], float rstd, const float* g1, const float* g2, const float* cs, u32x4& o0, u32x4& o1) {
  const f32x4 c0 = *(const f32x4*)cs, c1 = *(const f32x4*)(cs + 4), s0 = *(const f32x4*)(cs + 32), s1 = *(const f32x4*)(cs + 36);
  const f32x4 ga0 = *(const f32x4*)g1, ga1 = *(const f32x4*)(g1 + 4), gb0 = *(const f32x4*)g2, gb1 = *(const f32x4*)(g2 + 4);
  float y1[8], y2[8];
#pragma unroll
  for (int j = 0; j < 8; ++j) {
    const float c = j < 4 ? c0[j & 3] : c1[j & 3], sn = j < 4 ? s0[j & 3] : s1[j & 3];
    const float a = x1[j] * rstd * (j < 4 ? ga0[j & 3] : ga1[j & 3]), bb = x2[j] * rstd * (j < 4 ? gb0[j & 3] : gb1[j & 3]);
    y1[j] = a * c - bb * sn; y2[j] = bb * c + a * sn;
  }
  o0.x = pk_bf16(y1[0], y1[1]); o0.y = pk_bf16(y1[2], y1[3]); o0.z = pk_bf16(y1[4], y1[5]); o0.w = pk_bf16(y1[6], y1[7]);
  o1.x = pk_bf16(y2[0], y2[1]); o1.y = pk_bf16(y2[2], y2[3]); o1.z = pk_bf16(y2[4], y2[5]); o1.w = pk_bf16(y2[6], y2[7]);
}
DI void attn_item(LAS unsigned char* lds, const Params& p, int l, int item) {
  bf16_t* P = (bf16_t*)(p.ws + WS_PROJ);
  const float* ropec = (const float*)(p.ws + WS_ROPE);
  const int tid = opaque_tid(), wid = __builtin_amdgcn_readfirstlane(tid >> 6), lane = tid & 63, fr = lane & 15, fq = lane >> 4;
  const int blk = item & 63, kvh = (item >> 6) & 1, b = item >> 7;
  const size_t tokb = (size_t)b * SEQ;
  LAS bf16_t* Ks = (LAS bf16_t*)lds;
  LAS bf16_t* Vs = (LAS bf16_t*)(lds + 384 * AT_KLD * 2);
  const float* qg = p.qg + l * 64; const float* kg = p.kg + l * 64;
  __syncthreads();
  {
    u32x4 w[6];
#pragma unroll
    for (int it = 0; it < 6; ++it) { const int task = it * 512 + tid; const int kk = task >> 3, o8 = task & 7; const int pos = blk * 128 - 128 + kk;
      const int pc = pos < 0 ? 0 : (pos >= SEQ ? SEQ - 1 : pos);
      w[it] = *(const u32x4*)(P + (tokb + pc) * NP + C_VC + kvh * 64 + o8 * 8); }
#pragma unroll
    for (int it = 0; it < 6; ++it) { const int task = it * 512 + tid; const int kk = task >> 3, o8 = task & 7; *(LAS u32x4*)(Vs + kk * AT_VLD + o8 * 8) = w[it]; }
  }
  {
    u32x4 w0[3], w1[3];
#pragma unroll
    for (int it = 0; it < 3; ++it) { const int task = it * 512 + tid; const int kk = task >> 2, o = task & 3; const int pos = blk * 128 - 128 + kk;
      const int pc = pos < 0 ? 0 : (pos >= SEQ ? SEQ - 1 : pos);
      const bf16_t* src = P + (tokb + pc) * NP + C_KC + kvh * 64 + o * 8; w0[it] = *(const u32x4*)src; w1[it] = *(const u32x4*)(src + 32); }
#pragma unroll
    for (int it = 0; it < 3; ++it) { const int task = it * 512 + tid; const int kk = task >> 2, o = task & 3; const int pos = blk * 128 - 128 + kk;
      const float x1[8] = {bflo(w0[it].x), bfhi(w0[it].x), bflo(w0[it].y), bfhi(w0[it].y), bflo(w0[it].z), bfhi(w0[it].z), bflo(w0[it].w), bfhi(w0[it].w)};
      const float x2[8] = {bflo(w1[it].x), bfhi(w1[it].x), bflo(w1[it].y), bfhi(w1[it].y), bflo(w1[it].z), bfhi(w1[it].z), bflo(w1[it].w), bfhi(w1[it].w)};
      float ss = 0.f;
#pragma unroll
      for (int j = 0; j < 8; ++j) ss += x1[j] * x1[j] + x2[j] * x2[j];
      ss += __shfl_xor(ss, 1); ss += __shfl_xor(ss, 2);
      const float rstd = rsqrtf(ss * (1.0f / 64.0f) + EPS);
      const int pc = pos < 0 ? 0 : (pos >= SEQ ? SEQ - 1 : pos);
      u32x4 o0, o1; rope8(x1, x2, rstd, kg + o * 8, kg + 32 + o * 8, ropec + (size_t)pc * 64 + o * 8, o0, o1);
      *(LAS u32x4*)(Ks + kk * AT_KLD + o * 8) = o0; *(LAS u32x4*)(Ks + kk * AT_KLD + 32 + o * 8) = o1; }
  }
  float gq = fabsf(qg[lane]), gk = fabsf(kg[lane]);
#pragma unroll
  for (int o = 32; o >= 1; o >>= 1) { gq = fmaxf(gq, __shfl_xor(gq, o)); gk = fmaxf(gk, __shfl_xor(gk, o)); }
  const int hq = kvh * 4 + (wid & 3), half = wid >> 2;
  const float sinkv = p.sink[l * 8 + hq];
  const float mshift = fmaxf(8.0f * gq * gk, sinkv) * 1.4426950408889634f;
  bf16x8 qf[4][2];
  {
    u32x4 w0[4], w1[4];
#pragma unroll
    for (int qt = 0; qt < 4; ++qt) { const int pos = blk * 128 + half * 64 + qt * 16 + fr; const bf16_t* src = P + (tokb + pos) * NP + C_QC + hq * 64 + fq * 8; w0[qt] = *(const u32x4*)src; w1[qt] = *(const u32x4*)(src + 32); }
#pragma unroll
    for (int qt = 0; qt < 4; ++qt) {
      const int pos = blk * 128 + half * 64 + qt * 16 + fr;
      const float x1[8] = {bflo(w0[qt].x), bfhi(w0[qt].x), bflo(w0[qt].y), bfhi(w0[qt].y), bflo(w0[qt].z), bfhi(w0[qt].z), bflo(w0[qt].w), bfhi(w0[qt].w)};
      const float x2[8] = {bflo(w1[qt].x), bfhi(w1[qt].x), bflo(w1[qt].y), bfhi(w1[qt].y), bflo(w1[qt].z), bfhi(w1[qt].z), bflo(w1[qt].w), bfhi(w1[qt].w)};
      float ss = 0.f;
#pragma unroll
      for (int j = 0; j < 8; ++j) ss += x1[j] * x1[j] + x2[j] * x2[j];
      ss += __shfl_xor(ss, 16); ss += __shfl_xor(ss, 32);
      const float rstd = rsqrtf(ss * (1.0f / 64.0f) + EPS) * (0.125f * 1.4426950408889634f);
      u32x4 o0, o1; rope8(x1, x2, rstd, qg + fq * 8, qg + 32 + fq * 8, ropec + (size_t)pos * 64 + fq * 8, o0, o1);
      qf[qt][0] = __builtin_bit_cast(bf16x8, o0); qf[qt][1] = __builtin_bit_cast(bf16x8, o1);
    }
  }
  __syncthreads();
  f32x4 oacc[4][4];
  float lsum[4] = {0.f, 0.f, 0.f, 0.f};
#pragma unroll
  for (int a = 0; a < 4; ++a)
#pragma unroll
    for (int c = 0; c < 4; ++c) oacc[a][c] = (f32x4){0.f, 0.f, 0.f, 0.f};
  const int qs = half * 64;
  for (int kp = 0; kp < 12; ++kp) {
    const int k0 = kp * 32 - 128;
    if (k0 + 31 < qs - 128 || k0 > qs + 63 + 128) continue;
    const int kabs0 = blk * 128 + k0;
    if (kabs0 + 31 < 0 || kabs0 >= SEQ) continue;
    bf16x8 kf[2][2];
#pragma unroll
    for (int kt = 0; kt < 2; ++kt)
#pragma unroll
      for (int hh = 0; hh < 2; ++hh) kf[kt][hh] = *(const LAS bf16x8*)(Ks + (kp * 32 + kt * 16 + fr) * AT_KLD + hh * 32 + fq * 8);
    bf16x8 vf[4];
#pragma unroll
    for (int dt = 0; dt < 4; ++dt) { const LAS bf16_t* base = Vs + (kp * 32 + fq * 4 + (fr >> 2)) * AT_VLD + dt * 16 + (fr & 3) * 4; vf[dt] = tr_pair(base, base + 16 * AT_VLD); }
#pragma unroll
    for (int qt = 0; qt < 4; ++qt) {
      const int q0 = qs + qt * 16;
      const bool interior = (k0 + 31 - q0 <= 128) && (q0 + 15 - k0 <= 128) && (kabs0 >= 0) && (kabs0 + 31 < SEQ);
      const int qrel = q0 + fr;
      float pv[8];
#pragma unroll
      for (int kt = 0; kt < 2; ++kt) {
        f32x4 sc = {-mshift, -mshift, -mshift, -mshift};
        sc = mfma16(kf[kt][0], qf[qt][0], sc); sc = mfma16(kf[kt][1], qf[qt][1], sc);
        if (interior) {
#pragma unroll
          for (int j = 0; j < 4; ++j) { const float e = __builtin_amdgcn_exp2f(sc[j]); pv[kt * 4 + j] = e; lsum[qt] += e; }
        } else {
#pragma unroll
          for (int j = 0; j < 4; ++j) {
            const int krel = k0 + kt * 16 + fq * 4 + j; const int kab = blk * 128 + krel; const int d = krel - qrel;
            const bool ok = (d <= 128) && (d >= -128) && (kab >= 0) && (kab < SEQ);
            const float e = ok ? __builtin_amdgcn_exp2f(sc[j]) : 0.f;
            pv[kt * 4 + j] = e; lsum[qt] += e;
          }
        }
      }
      u32x4 pw; pw.x = pk_bf16(pv[0], pv[1]); pw.y = pk_bf16(pv[2], pv[3]); pw.z = pk_bf16(pv[4], pv[5]); pw.w = pk_bf16(pv[6], pv[7]);
      const bf16x8 pb = __builtin_bit_cast(bf16x8, pw);
#pragma unroll
      for (int dt = 0; dt < 4; ++dt) oacc[dt][qt] = mfma16(vf[dt], pb, oacc[dt][qt]);
    }
  }
  const float esink = __builtin_amdgcn_exp2f(sinkv * 1.4426950408889634f - mshift);
  u32x2 zz[4][4];
#pragma unroll
  for (int qt = 0; qt < 4; ++qt)
#pragma unroll
    for (int dt = 0; dt < 4; ++dt) { const int pos = blk * 128 + half * 64 + qt * 16 + fr; zz[qt][dt] = *(const u32x2*)(P + (tokb + pos) * NP + hq * 64 + dt * 16 + fq * 4 + C_ZC); }
#pragma unroll
  for (int qt = 0; qt < 4; ++qt) {
    float ls = lsum[qt]; ls += __shfl_xor(ls, 16); ls += __shfl_xor(ls, 32);
    const float inv = 1.0f / (ls + esink);
    const int pos = blk * 128 + half * 64 + qt * 16 + fr;
#pragma unroll
    for (int dt = 0; dt < 4; ++dt) {
      const size_t off = (tokb + pos) * NP + hq * 64 + dt * 16 + fq * 4;
      const u32x2 z = zz[qt][dt];
      u32x2 w; w.x = pk_bf16(oacc[dt][qt][0] * inv * fsilu(bflo(z.x)), oacc[dt][qt][1] * inv * fsilu(bfhi(z.x))); w.y = pk_bf16(oacc[dt][qt][2] * inv * fsilu(bflo(z.y)), oacc[dt][qt][3] * inv * fsilu(bfhi(z.y)));
      *(u32x2*)(P + off + C_QC) = w;
    }
  }
}

constexpr int SCR = 512, NSC = SEQ / SCR, NSUB = SCR / 64;
constexpr int H_QLD = 144, H_TLD = 80;
constexpr int H_QS = 0, H_KS = H_QS + 64 * H_QLD * 2, H_KT = H_KS + 64 * H_QLD * 2, H_VT = H_KT + 128 * H_TLD * 2, H_ST = H_VT + 128 * H_TLD * 2,
              H_SEG = H_ST + 128 * H_QLD * 2, H_SSQ = H_SEG + 2 * 4 * 128 * 4, H_GN = H_SSQ + 2 * 64 * 4, H_END = H_GN + 128 * 4;
static_assert(H_END <= LDS_BYTES, "hgrn lds");

template <bool OUT>
DI void hgrn_super(LAS unsigned char* lds, const Params& p, int l, int b, int h, int nn, int dir, f32x4 (&S)[8], float& btot) {
  bf16_t* P = (bf16_t*)(p.ws + WS_PROJ);
  const int tid = opaque_tid(), wid = __builtin_amdgcn_readfirstlane(tid >> 6), lane = tid & 63, fr = lane & 15, fq = lane >> 4;
  const int d = tid & 127, seg = tid >> 7;
  LAS bf16_t* Qs = (LAS bf16_t*)(lds + H_QS); LAS bf16_t* Ks = (LAS bf16_t*)(lds + H_KS); LAS bf16_t* KT = (LAS bf16_t*)(lds + H_KT);
  LAS bf16_t* Vt = (LAS bf16_t*)(lds + H_VT); LAS bf16_t* St = (LAS bf16_t*)(lds + H_ST); LAS float* segtot2 = (LAS float*)(lds + H_SEG); LAS float* ssqb = (LAS float*)(lds + H_SSQ);
  const size_t tokbase = (size_t)b * SEQ + (size_t)nn * SCR;
  const int lfcol = (dir ? C_LFB : C_LFF) + h * 128;
  LAS float* gnl = (LAS float*)(lds + H_GN);
  if (OUT && dir == 1 && tid < 128) gnl[tid] = p.hg_gain[(size_t)l * 512 + h * 128 + tid];
  unsigned short lfr[16], vv[16], qr[16];
  const char* hbase = (const char*)(P + tokbase * NP + h * 128);
  const unsigned lfo = (unsigned)((dir ? C_LFB : C_LFF) * 2), iao = (unsigned)(C_IA * 2);
  const int rstep = dir ? -(NP * 2) : (NP * 2);
#define H_LOADS(CC) do { const int r0_ = (CC) * 64 + seg * 16; unsigned vo_ = (unsigned)((dir ? (SCR - 1) - r0_ : r0_) * (NP * 2) + d * 2); \
    _Pragma("unroll") for (int i = 0; i < 16; ++i) { const char* a_ = hbase + vo_; lfr[i] = *(const bf16_t*)(a_ + lfo); vv[i] = *(const bf16_t*)(a_ + iao); if (OUT) qr[i] = *(const bf16_t*)a_; vo_ += (unsigned)rstep; } } while (0)
  H_LOADS(0);
  for (int cc = 0; cc < NSUB; ++cc) {
    float lfv[16], loc[16], qv[16];
    float run = 0.f;
#pragma unroll
    for (int i = 0; i < 16; ++i) { lfv[i] = h2f(lfr[i]); if (OUT) qv[i] = bf2f(qr[i]); run += lfv[i]; loc[i] = run; }
    LAS float* segtot = segtot2 + (cc & 1) * 512;
    segtot[seg * 128 + d] = run;
    lds_barrier();
    {
      const float s0 = segtot[d], s1 = segtot[128 + d], s2 = segtot[256 + d], s3 = segtot[384 + d];
      const float bmid = s0 + s1, bend = bmid + s2 + s3;
      const float off = (seg > 0 ? s0 : 0.f) + (seg > 1 ? s1 : 0.f) + (seg > 2 ? s2 : 0.f);
      btot += bend;
      const float dof = off - bmid;
      unsigned ktw[8];
#pragma unroll
      for (int i = 0; i < 16; i += 2) {
        const float d0 = dof + loc[i], d1 = dof + loc[i + 1];
        const float k0 = 1.0f - __builtin_amdgcn_exp2f(lfv[i]), k1 = 1.0f - __builtin_amdgcn_exp2f(lfv[i + 1]);
        const unsigned kw = pk_bf16(k0 * __builtin_amdgcn_exp2f(fminf(-d0, 115.f)), k1 * __builtin_amdgcn_exp2f(fminf(-d1, 115.f)));
        ktw[i >> 1] = kw;
        if (OUT) { const int r = seg * 16 + i;
          const unsigned qw = pk_bf16(qv[i] * __builtin_amdgcn_exp2f(fminf(d0, 115.f)), qv[i + 1] * __builtin_amdgcn_exp2f(fminf(d1, 115.f)));
          Ks[r * H_QLD + d] = (bf16_t)(kw & 0xffffu); Ks[(r + 1) * H_QLD + d] = (bf16_t)(kw >> 16);
          Qs[r * H_QLD + d] = (bf16_t)(qw & 0xffffu); Qs[(r + 1) * H_QLD + d] = (bf16_t)(qw >> 16); }
      }
      u32x4 w0, w1;
      w0.x = ktw[0]; w0.y = ktw[1]; w0.z = ktw[2]; w0.w = ktw[3]; w1.x = ktw[4]; w1.y = ktw[5]; w1.z = ktw[6]; w1.w = ktw[7];
      *(LAS u32x4*)(KT + d * H_TLD + seg * 16) = w0; *(LAS u32x4*)(KT + d * H_TLD + seg * 16 + 8) = w1;
      w0.x = vv[0] | ((unsigned)vv[1] << 16); w0.y = vv[2] | ((unsigned)vv[3] << 16); w0.z = vv[4] | ((unsigned)vv[5] << 16); w0.w = vv[6] | ((unsigned)vv[7] << 16);
      w1.x = vv[8] | ((unsigned)vv[9] << 16); w1.y = vv[10] | ((unsigned)vv[11] << 16); w1.z = vv[12] | ((unsigned)vv[13] << 16); w1.w = vv[14] | ((unsigned)vv[15] << 16);
      *(LAS u32x4*)(Vt + d * H_TLD + seg * 16) = w0; *(LAS u32x4*)(Vt + d * H_TLD + seg * 16 + 8) = w1;
    }
    if (cc < NSUB - 1) H_LOADS(cc + 1);
    float e1[4], e2[4], em[4];
#pragma unroll
    for (int j = 0; j < 4; ++j) { const int dk = wid * 16 + fq * 4 + j; const float s0 = segtot[dk], s1 = segtot[128 + dk], s2 = segtot[256 + dk], s3 = segtot[384 + dk];
      em[j] = __builtin_amdgcn_exp2f(s0 + s1); e2[j] = __builtin_amdgcn_exp2f(s2 + s3); e1[j] = __builtin_amdgcn_exp2f(s0 + s1 + s2 + s3); }
    if (OUT) {
#pragma unroll
      for (int dvt = 0; dvt < 8; ++dvt) { u32x2 w; w.x = pk_bf16(S[dvt][0] * em[0], S[dvt][1] * em[1]); w.y = pk_bf16(S[dvt][2] * em[2], S[dvt][3] * em[3]);
        *(LAS u32x2*)(St + (dvt * 16 + fr) * H_QLD + wid * 16 + fq * 4) = w; }
    }
    lds_barrier();
    f32x4 oo[4];
    const int tt = wid & 3, dh = wid >> 2;
    u32x2 zzv[4]; unsigned long long ofv[4];
    if (OUT && dir == 1) {
      const int r = cc * 64 + tt * 16 + fr; const size_t tok = tokbase + (size_t)((SCR - 1) - r);
#pragma unroll
      for (int i = 0; i < 4; ++i) { const int col = h * 128 + dh * 64 + i * 16 + fq * 4;
        zzv[i] = *(const u32x2*)(P + tok * NP + C_ZA + col);
        ofv[i] = __hip_atomic_load((const unsigned long long*)(P + tok * NP + C_LFF + col), __ATOMIC_RELAXED, __HIP_MEMORY_SCOPE_AGENT); }
    }
    if (OUT) {
      bf16x8 qf[4];
#pragma unroll
      for (int kk = 0; kk < 4; ++kk) qf[kk] = *(const LAS bf16x8*)(Qs + (tt * 16 + fr) * H_QLD + kk * 32 + fq * 8);
      f32x4 pt[4];
#pragma unroll
      for (int st = 0; st < 4; ++st) {
        pt[st] = (f32x4){0.f, 0.f, 0.f, 0.f};
        if (st <= tt) {
          f32x4 a = {0.f, 0.f, 0.f, 0.f};
#pragma unroll
          for (int kk = 0; kk < 4; ++kk) { const bf16x8 kf = *(const LAS bf16x8*)(Ks + (st * 16 + fr) * H_QLD + kk * 32 + fq * 8); a = mfma16(kf, qf[kk], a); }
#pragma unroll
          for (int j = 0; j < 4; ++j) pt[st][j] = (st * 16 + fq * 4 + j <= tt * 16 + fr) ? a[j] : 0.f;
        }
      }
      bf16x8 pb[2];
#pragma unroll
      for (int pp = 0; pp < 2; ++pp) { u32x4 w; w.x = pk_bf16(pt[2 * pp][0], pt[2 * pp][1]); w.y = pk_bf16(pt[2 * pp][2], pt[2 * pp][3]); w.z = pk_bf16(pt[2 * pp + 1][0], pt[2 * pp + 1][1]); w.w = pk_bf16(pt[2 * pp + 1][2], pt[2 * pp + 1][3]);
        pb[pp] = __builtin_bit_cast(bf16x8, w); }
#pragma unroll
      for (int i = 0; i < 4; ++i) {
        const int dvt = dh * 4 + i; f32x4 a = {0.f, 0.f, 0.f, 0.f};
#pragma unroll
        for (int pp = 0; pp < 2; ++pp) if (2 * pp <= tt) {
          const bf16x4 v0 = *(const LAS bf16x4*)(Vt + (dvt * 16 + fr) * H_TLD + pp * 32 + fq * 4), v1 = *(const LAS bf16x4*)(Vt + (dvt * 16 + fr) * H_TLD + pp * 32 + 16 + fq * 4);
          const bf16x8 vf = {v0[0], v0[1], v0[2], v0[3], v1[0], v1[1], v1[2], v1[3]};
          a = mfma16(vf, pb[pp], a); }
#pragma unroll
        for (int kk = 0; kk < 4; ++kk) { const bf16x8 sf = *(const LAS bf16x8*)(St + (dvt * 16 + fr) * H_QLD + kk * 32 + fq * 8); a = mfma16(sf, qf[kk], a); }
        oo[i] = a;
      }
      const int r = cc * 64 + tt * 16 + fr; const size_t tok = tokbase + (dir ? (SCR - 1) - r : r);
      if (dir == 0) {
#pragma unroll
        for (int i = 0; i < 4; ++i) { u32x2 w; w.x = pk_bf16(oo[i][0], oo[i][1]); w.y = pk_bf16(oo[i][2], oo[i][3]);
          *(u32x2*)(P + tok * NP + C_LFF + h * 128 + dh * 64 + i * 16 + fq * 4) = w; }
      } else {
        float ss = 0.f;
#pragma unroll
        for (int i = 0; i < 4; ++i) {
          const unsigned long long ww = ofv[i];
          const unsigned lo = (unsigned)ww, hi = (unsigned)(ww >> 32);
          oo[i][0] += bflo(lo); oo[i][1] += bfhi(lo); oo[i][2] += bflo(hi); oo[i][3] += bfhi(hi);
          ss += (oo[i][0] * oo[i][0] + oo[i][1] * oo[i][1]) + (oo[i][2] * oo[i][2] + oo[i][3] * oo[i][3]);
        }
        ss += __shfl_xor(ss, 16); ss += __shfl_xor(ss, 32);
        if (fq == 0) ssqb[dh * 64 + tt * 16 + fr] = ss;
      }
    }
#pragma unroll
    for (int dvt = 0; dvt < 8; ++dvt) {
      f32x4 a = {0.f, 0.f, 0.f, 0.f};
#pragma unroll
      for (int kk = 0; kk < 2; ++kk) { const bf16x8 kf = *(const LAS bf16x8*)(KT + (wid * 16 + fr) * H_TLD + kk * 32 + fq * 8), vf = *(const LAS bf16x8*)(Vt + (dvt * 16 + fr) * H_TLD + kk * 32 + fq * 8);
        a = mfma16(kf, vf, a); }
#pragma unroll
      for (int j = 0; j < 4; ++j) S[dvt][j] = e1[j] * S[dvt][j] + e2[j] * a[j];
    }
    if (OUT && dir == 1) {
      lds_barrier();
      const int r = cc * 64 + tt * 16 + fr; const size_t tok = tokbase + (size_t)((SCR - 1) - r);
      const float tot = ssqb[tt * 16 + fr] + ssqb[64 + tt * 16 + fr];
      const float rs = rsqrtf(tot * (1.0f / 128.0f) + EPS);
#pragma unroll
      for (int i = 0; i < 4; ++i) {
        const int col = h * 128 + dh * 64 + i * 16 + fq * 4;
        const f32x4 gn = *(const LAS f32x4*)(gnl + dh * 64 + i * 16 + fq * 4);
        const u32x2 zz = zzv[i];
        u32x2 w; w.x = pk_bf16(oo[i][0] * rs * gn[0] * fsilu(bflo(zz.x)), oo[i][1] * rs * gn[1] * fsilu(bfhi(zz.x))); w.y = pk_bf16(oo[i][2] * rs * gn[2] * fsilu(bflo(zz.y)), oo[i][3] * rs * gn[3] * fsilu(bfhi(zz.y)));
        *(u32x2*)(P + tok * NP + C_QA + col) = w;
      }
    }
  }
}


#define XB_TMO      128
#define XB_XCNT(j)  (256  + 64 * (j))
#define XB_XSUB(j)  (1280 + 64 * (j))
#define XB_XGEN(j)  (2304 + 64 * (j))
#define XB_TOP      3328
#define XB_TOPGEN   3392
#define XCD_BAR_WORDS 3456
#define XB_SPIN_CAP (1u << 22)
DI unsigned xb_ld(unsigned* p) { return __hip_atomic_load(p, __ATOMIC_RELAXED, __HIP_MEMORY_SCOPE_AGENT); }
DI unsigned xb_add(unsigned* p, unsigned v) { return __hip_atomic_fetch_add(p, v, __ATOMIC_RELAXED, __HIP_MEMORY_SCOPE_AGENT); }
DI unsigned xb_xcc_id() { return (unsigned)__builtin_amdgcn_s_getreg((3 << 11) | 20) & 0xFu; }
#define XB_SPIN(cond, bar) do { unsigned _sp = 0; while (cond) { __builtin_amdgcn_s_sleep(1); \
    if ((++_sp & 255u) == 0u) { if (xb_ld(&(bar)[XB_TMO])) break; if (_sp > XB_SPIN_CAP) { atomicAdd(&(bar)[XB_TMO], 1u); break; } } } } while (0)
struct XcdBarrier { unsigned* bar; unsigned x; volatile LAS unsigned* st; };
DI XcdBarrier xcd_barrier_post(unsigned* bar, volatile LAS unsigned* st) {
  XcdBarrier b; b.bar = bar; b.x = xb_xcc_id(); b.st = st;
  if (threadIdx.x == 0) (void)xb_add(&bar[XB_XCNT(b.x)], 1u);
  return b;
}
DI void xcd_barrier_complete(unsigned* bar, unsigned x, unsigned& nloc, unsigned& nx) {
  const unsigned G = gridDim.x;
  unsigned sum, cnt, mine, sp = 0u;
  for (;;) {
    sum = 0u; cnt = 0u; mine = 0u;
#pragma unroll
    for (unsigned j = 0; j < 16; ++j) { const unsigned c = xb_ld(&bar[XB_XCNT(j)]); sum += c; cnt += (c > 0u) ? 1u : 0u; mine = (j == x) ? c : mine; }
    if (sum == G) break;
    __builtin_amdgcn_s_sleep(1);
    if ((++sp & 255u) == 0u) { if (xb_ld(&bar[XB_TMO])) break; if (sp > XB_SPIN_CAP) { atomicAdd(&bar[XB_TMO], 1u); break; } }
  }
  nloc = mine > 0u ? mine : 1u; nx = cnt > 0u ? cnt : 1u;
}
DI void xcd_barrier(const XcdBarrier& b) {
  asm volatile("s_waitcnt vmcnt(0)" ::: "memory");
  __syncthreads();
  if (threadIdx.x == 0) {
    unsigned* bar = b.bar;
    __builtin_amdgcn_s_waitcnt(0);
    unsigned nloc = b.st[0], nx = b.st[1];
    if (nloc == 0u) { xcd_barrier_complete(bar, b.x, nloc, nx); b.st[0] = nloc; b.st[1] = nx; }
    const unsigned old = xb_add(&bar[XB_XSUB(b.x)], 1u);
    const unsigned gen = old / nloc;
    if (old + 1u == (gen + 1u) * nloc) {
      __builtin_amdgcn_fence(__ATOMIC_RELEASE, "agent");
      asm volatile("s_waitcnt vmcnt(0)" ::: "memory");
      const unsigned og = xb_add(&bar[XB_TOP], 1u);
      const unsigned tg = og / nx;
      if (og + 1u == (tg + 1u) * nx) xb_add(&bar[XB_TOPGEN], 1u);
      else XB_SPIN(xb_ld(&bar[XB_TOPGEN]) == tg, bar);
      __builtin_amdgcn_fence(__ATOMIC_ACQUIRE, "agent");
      xb_add(&bar[XB_XGEN(b.x)], 1u);
      asm volatile("s_waitcnt vmcnt(0)" ::: "memory");
    } else {
      XB_SPIN(xb_ld(&bar[XB_XGEN(b.x)]) == gen, bar);
      __builtin_amdgcn_fence(__ATOMIC_ACQUIRE, "agent");
      asm volatile("s_waitcnt vmcnt(0)" ::: "memory");
    }
  }
  __syncthreads();
}
#ifndef PHM
#define PHM 0xffff
#endif
__global__ void __launch_bounds__(512, 2) fwd_mega(Params p) {
  extern __shared__ __attribute__((aligned(16))) unsigned char lds_raw[];
  LAS unsigned char* lds = (LAS unsigned char*)lds_raw;
  cg::grid_group grid = cg::this_grid();
  if (threadIdx.x < 4) ((LAS unsigned*)(lds + LDS_XB))[threadIdx.x] = 0u;
  __syncthreads();
  const XcdBarrier xbar = xcd_barrier_post((unsigned*)(p.ws + WS_BAR), (volatile LAS unsigned*)(lds + LDS_XB));
  const int G = gridDim.x, bid = blockIdx.x;
  const long gthreads = (long)G * 512;
#define LANEVARS const int tid = opaque_tid(); const int wid = __builtin_amdgcn_readfirstlane(tid >> 6), lane = tid & 63; const long gtid = (long)bid * 512 + tid; (void)wid; (void)lane; (void)gtid
  unsigned char* ws = p.ws;
  bf16_t* P = (bf16_t*)(ws + WS_PROJ); bf16_t* XB = (bf16_t*)(ws + WS_XB);
  bf16_t* WIN = (bf16_t*)(ws + WS_WIN); bf16_t* WG = (bf16_t*)(ws + WS_WG); bf16_t* WBR = (bf16_t*)(ws + WS_WBR); bf16_t* WOUT = (bf16_t*)(ws + WS_WOUT);
  float* ST = (float*)(ws + WS_ST); float* DD = (float*)(ws + WS_DD); float* SSQ = (float*)(ws + WS_SSQ);
  float* ROPE = (float*)(ws + WS_ROPE); float* LB = (float*)(ws + WS_LB);

  {
    LANEVARS;
    for (int r = (bid * 8 + wid) * 2; r < T_TOK; r += G * 16) {
      f32x4 v[2][4];
#pragma unroll
      for (int rr = 0; rr < 2; ++rr)
#pragma unroll
        for (int i = 0; i < 4; ++i) v[rr][i] = *(const f32x4*)(p.x + (size_t)(r + rr) * DM + i * 256 + lane * 4);
#pragma unroll
      for (int rr = 0; rr < 2; ++rr) {
        float ss = 0.f;
#pragma unroll
        for (int i = 0; i < 4; ++i) {
          u32x2 w; w.x = pk_bf16(v[rr][i][0], v[rr][i][1]); w.y = pk_bf16(v[rr][i][2], v[rr][i][3]);
          *(u32x2*)(XB + (size_t)(r + rr) * DM + i * 256 + lane * 4) = w;
          ss += (v[rr][i][0] * v[rr][i][0] + v[rr][i][1] * v[rr][i][1]) + (v[rr][i][2] * v[rr][i][2] + v[rr][i][3] * v[rr][i][3]);
        }
#pragma unroll
        for (int o = 32; o >= 1; o >>= 1) ss += __shfl_xor(ss, o);
        if (lane < 16) SSQ[(size_t)(r + rr) * 16 + lane] = lane == 0 ? ss : 0.f;
      }
    }
    for (long i = gtid; i < (long)SEQ * 32; i += gthreads) {
      const int pos = (int)(i >> 5), j = (int)(i & 31);
      const float invf = powf(10000.0f, -(float)j / 32.0f);
      const float ang = (float)pos * invf;
      double rev = (double)ang * 0.15915494309189535; rev -= floor(rev);
      ROPE[(size_t)pos * 64 + j] = __builtin_amdgcn_cosf((float)rev); ROPE[(size_t)pos * 64 + 32 + j] = __builtin_amdgcn_sinf((float)rev);
    }
    for (long i = gtid; i < 1024; i += gthreads) {
      const float a0 = p.lb_logits[i], a1 = p.lb_logits[1024 + i], a2 = p.lb_logits[2048 + i], a3 = p.lb_logits[3072 + i];
      const float mx = fmaxf(fmaxf(a0, a1), fmaxf(a2, a3));
      const float e0 = expf(a0 - mx), e1 = expf(a1 - mx), e2 = expf(a2 - mx), e3 = expf(a3 - mx); const float inv = 1.0f / (e0 + e1 + e2 + e3);
      LB[i] = 0.f; LB[1024 + i] = e1 * inv; LB[2048 + i] = (e1 + e2) * inv; LB[3072 + i] = (e1 + e2 + e3) * inv;
    }
    convert_w(p.w_in, NIN, DM, WIN, NP, 1, 0, p.norm_gain, gtid, gthreads);
  }
  if (p.use_cg_sync) grid.sync(); else xcd_barrier(xbar);

  for (int l = 0; l < DEPTH; ++l) {
    if (2 * bid >= G) { LANEVARS;
    const long ct = (long)(bid - (G + 1) / 2) * 512 + tid, cth = (long)(G - (G + 1) / 2) * 512;
    convert_w(p.w_in + (size_t)l * DM * NIN, NIN, DM, WG, 3072, 0, NP, p.norm_gain + l * DM, ct, cth);
    convert_w(p.wba + (size_t)l * 512 * DM, DM, 512, WBR, 1024, 0, 0, nullptr, ct, cth);
    convert_w(p.wbb + (size_t)l * 512 * DM, DM, 512, WBR + 1024 * 512, 1024, 0, 0, nullptr, ct, cth);
    convert_w(p.wbc + (size_t)l * 512 * DM, DM, 512, WBR + 2 * 1024 * 512, 1024, 0, 0, nullptr, ct, cth);
    convert_w(p.w_out + (size_t)l * DM * DM, DM, DM, WOUT, 1024, 0, 0, nullptr, ct, cth); }
    if (PHM & 1) {
      GenPlain gen{(const char*)XB, (const char*)WIN, DM * 2, DM * 2, 16, 128, NP / 256, G, bid};
      EpiProj epi{P, SSQ, LB + l * 1024};
      gemm_phase<1>(lds, gen, epi, SSQ);
    }
    xcd_barrier(xbar);
    if (l + 1 < DEPTH) { LANEVARS; convert_w(p.w_in + (size_t)(l + 1) * DM * NIN, NIN, DM, WIN, NP, 1, 0, p.norm_gain + (l + 1) * DM, gtid, gthreads); }
    if (PHM & 2) for (int item = bid; item < 256; item += G) sgu_item(lds, p, l, item);
    if (PHM & 4) for (int item = bid; item < 512; item += G) attn_item(lds, p, l, item);
    if (PHM & 8) for (int item = bid; item < 32 * NSC; item += G) {
      LANEVARS;
      const int seq = item / NSC, n = item % NSC, dir = seq & 1, bh = seq >> 1, b = bh >> 2, h = bh & 3; const int nn = dir ? NSC - 1 - n : n;
      f32x4 S[8];
#pragma unroll
      for (int i = 0; i < 8; ++i) S[i] = (f32x4){0.f, 0.f, 0.f, 0.f};
      float btot = 0.f;
      hgrn_super<false>(lds, p, l, b, h, nn, dir, S, btot);
      float* dst = ST + ((size_t)seq * NSC + n) * 16384;
      const int fr = lane & 15, fq = lane >> 4;
#pragma unroll
      for (int dvt = 0; dvt < 8; ++dvt)
#pragma unroll
        for (int j = 0; j < 4; ++j) dst[(wid * 16 + fq * 4 + j) * 128 + dvt * 16 + fr] = S[dvt][j];
      if (tid < 128) DD[((size_t)seq * NSC + n) * 128 + tid] = __builtin_amdgcn_exp2f(btot);
    }
    xcd_barrier(xbar);
    { LANEVARS;
    for (long e = gtid; e < 32L * 4096; e += gthreads) {
      const int seq = (int)(e >> 12), q4 = (int)(e & 4095); const int dk = q4 >> 5;
      float* base = ST + (size_t)seq * NSC * 16384 + (size_t)q4 * 4; const float* dbase = DD + (size_t)seq * NSC * 128 + dk;
      f32x4 carry = {0.f, 0.f, 0.f, 0.f};
      for (int nb = 0; nb < NSC; nb += 16) {
        f32x4 u[16]; float dc[16];
#pragma unroll
        for (int i = 0; i < 16; ++i) { u[i] = *(const f32x4*)(base + (size_t)(nb + i) * 16384); dc[i] = dbase[(nb + i) * 128]; }
#pragma unroll
        for (int i = 0; i < 16; ++i) { *(f32x4*)(base + (size_t)(nb + i) * 16384) = carry; carry = carry * dc[i] + u[i]; }
      }
    } }
    xcd_barrier(xbar);
    if (PHM & 16) for (int item = bid; item < 16 * NSC; item += G) {
      LANEVARS;
      const int nn = item % NSC, bh = item / NSC, b = bh >> 2, h = bh & 3;
      const int fr = lane & 15, fq = lane >> 4;
      for (int dir = 0; dir < 2; ++dir) {
        const int seq = bh * 2 + dir, n = dir ? NSC - 1 - nn : nn;
        const float* src = ST + ((size_t)seq * NSC + n) * 16384;
        f32x4 S[8];
#pragma unroll
        for (int dvt = 0; dvt < 8; ++dvt)
#pragma unroll
          for (int j = 0; j < 4; ++j) S[dvt][j] = src[(wid * 16 + fq * 4 + j) * 128 + dvt * 16 + fr];
        float btot = 0.f;
        hgrn_super<true>(lds, p, l, b, h, nn, dir, S, btot);
      }
    }
    xcd_barrier(xbar);
    if (PHM & 32) {
      GenMerge gen{(const char*)XB, (const char*)P, (const char*)WG, (const char*)WBR, G, bid};
      EpiMerge epi{P, SSQ, ws + WS_ST + (size_t)bid * 262144};
      gemm_phase<2>(lds, gen, epi, SSQ);
    }
    xcd_barrier(xbar);
    if (PHM & 64) {
      GenPlain gen{(const char*)(P + C_MERGED), (const char*)WOUT, NP * 2, DM * 2, 16, 128, 4, G, bid};
      EpiOut epi{p.x, p.out, XB, SSQ, l == 0 ? 1 : 0, l == DEPTH - 1 ? 1 : 0};
      gemm_phase<0>(lds, gen, epi, SSQ);
    }
    if (l + 1 < DEPTH) xcd_barrier(xbar);
  }
}

extern "C" void kernel_launch(void* const* d_in, const int* in_sizes, int n_in, void* d_out, int out_size,
                              void* d_ws, size_t ws_size, hipStream_t stream) {
  static int grid_blocks = 0;
  if (!grid_blocks) {
    int dev = 0, cus = 0, per_cu = 0;
    (void)hipGetDevice(&dev);
    (void)hipDeviceGetAttribute(&cus, hipDeviceAttributeMultiprocessorCount, dev);
    (void)hipFuncSetAttribute((const void*)fwd_mega, hipFuncAttributeMaxDynamicSharedMemorySize, LDS_BYTES);
    (void)hipOccupancyMaxActiveBlocksPerMultiprocessor(&per_cu, (const void*)fwd_mega, 512, LDS_BYTES);
    (void)hipGetLastError();
    grid_blocks = cus > 0 ? cus : 256;
    if (ws_size < WS_END) { fprintf(stderr, "workspace too small: %zu < %zu\n", ws_size, (size_t)WS_END); grid_blocks = -1; }
  }
  if (grid_blocks < 0) return;
  Params p{};
  p.x = (const float*)d_in[0]; p.w_in = (const float*)d_in[1]; p.norm_gain = (const float*)d_in[2]; p.lb_logits = (const float*)d_in[3];
  p.hg_gain = (const float*)d_in[4]; p.sg_g = (const float*)d_in[5]; p.sg_b = (const float*)d_in[6]; p.w_sp = (const float*)d_in[7];
  p.b_sp = (const float*)d_in[8]; p.qg = (const float*)d_in[9]; p.kg = (const float*)d_in[10]; p.sink = (const float*)d_in[11];
  p.wba = (const float*)d_in[12]; p.wbb = (const float*)d_in[13]; p.wbc = (const float*)d_in[14]; p.w_out = (const float*)d_in[15];
  p.out = (float*)d_out; p.ws = (unsigned char*)d_ws;
  (void)hipMemsetAsync((unsigned char*)d_ws + WS_BAR, 0, 3456 * 4, stream);
  void* args[] = {&p};
  hipError_t e = hipLaunchCooperativeKernel((const void*)fwd_mega, dim3(grid_blocks), dim3(512), args, LDS_BYTES, stream);
  if (e != hipSuccess) fprintf(stderr, "cooperative launch failed: %s (grid %d)\n", hipGetErrorString(e), grid_blocks);
}
```

```cpp
#include <hip/hip_runtime.h>
#include <hip/hip_cooperative_groups.h>
#include <cstdio>
namespace cg = cooperative_groups;

#define LAS __attribute__((address_space(3)))
#define DI __device__ __forceinline__
typedef unsigned short bf16_t;
typedef short bf16x8 __attribute__((ext_vector_type(8)));
typedef short bf16x4 __attribute__((ext_vector_type(4)));
typedef float f32x4 __attribute__((ext_vector_type(4)));
typedef float f32x2 __attribute__((ext_vector_type(2)));
typedef unsigned u32x4 __attribute__((ext_vector_type(4)));
typedef unsigned u32x2 __attribute__((ext_vector_type(2)));
typedef __bf16 bfv2 __attribute__((ext_vector_type(2)));

constexpr int T_TOK = 32768, SEQ = 8192, DM = 1024, DEPTH = 4;
constexpr int NP = 5376;
constexpr int NIN = 8448;
constexpr float EPS = 1e-6f;
constexpr int C_QA = 0, C_IA = 512, C_LFF = 1024, C_LFB = 1536, C_ZA = 2048, C_UB = 2560, C_ZB = 3072, C_VB = 3584,
              C_QC = 4096, C_ZC = 4608, C_KC = 5120, C_VC = 5248;
constexpr int C_MERGED = 1024;
constexpr int C_GSCR = 3072;

constexpr size_t WS_PROJ = 0;
constexpr size_t WS_XB   = WS_PROJ + (size_t)T_TOK * NP * 2;
constexpr size_t WS_WIN  = WS_XB + (size_t)T_TOK * DM * 2;
constexpr size_t WS_WG   = WS_WIN + (size_t)NP * DM * 2;
constexpr size_t WS_WBR  = WS_WG + (size_t)3072 * DM * 2;
constexpr size_t WS_WOUT = WS_WBR + (size_t)3 * 1024 * 512 * 2;
constexpr size_t WS_ST   = WS_WOUT + (size_t)1024 * 1024 * 2;
constexpr size_t WS_DD   = WS_ST + (size_t)32 * 32 * 16384 * 4;
constexpr size_t WS_SSQ  = WS_DD + (size_t)32 * 32 * 128 * 4;
constexpr size_t WS_ROPE = WS_SSQ + (size_t)16 * T_TOK * 4;
constexpr size_t WS_LB   = WS_ROPE + (size_t)SEQ * 64 * 4;
constexpr size_t WS_BAR  = WS_LB + (size_t)DEPTH * 1024 * 4;
constexpr size_t WS_END  = WS_BAR + (size_t)3456 * 4;

constexpr int LDS_BYTES = 148 * 1024;
constexpr int LDS_RSB = 128 * 1024;
constexpr int LDS_XB = LDS_BYTES - 16;

struct Params {
  const float* x; const float* w_in; const float* norm_gain; const float* lb_logits; const float* hg_gain;
  const float* sg_g; const float* sg_b; const float* w_sp; const float* b_sp; const float* qg; const float* kg;
  const float* sink; const float* wba; const float* wbb; const float* wbc; const float* w_out;
  float* out; unsigned char* ws;
  int use_cg_sync; int pad0;
};

DI unsigned pk_bf16(float lo, float hi) { f32x2 v = {lo, hi}; bfv2 b = __builtin_convertvector(v, bfv2); return __builtin_bit_cast(unsigned, b); }
DI bf16_t f2bf(float f) { return (bf16_t)(pk_bf16(f, 0.f) & 0xffffu); }
DI float bf2f(unsigned short b) { return __uint_as_float(((unsigned)b) << 16); }
DI float bflo(unsigned w) { return __uint_as_float(w << 16); }
DI float bfhi(unsigned w) { return __uint_as_float(w & 0xffff0000u); }
DI unsigned short f2h(float f) { _Float16 h = (_Float16)f; return __builtin_bit_cast(unsigned short, h); }
DI float h2f(unsigned short u) { _Float16 h = __builtin_bit_cast(_Float16, u); return (float)h; }
DI float fsigmoid(float v) { return __builtin_amdgcn_rcpf(1.0f + __builtin_amdgcn_exp2f(v * -1.4426950408889634f)); }
DI float fsilu(float v) { return v * __builtin_amdgcn_rcpf(1.0f + __builtin_amdgcn_exp2f(v * -1.4426950408889634f)); }
DI float fgelu(float v) { return v * __builtin_amdgcn_rcpf(1.0f + __builtin_amdgcn_exp2f(v * (-2.3022082f - 0.1029432f * v * v))); }
DI float row_rs(const float* ssqp, int r, int fq) {
  const f32x4 a = *(const f32x4*)(ssqp + (size_t)r * 16 + fq * 4);
  float t = (a[0] + a[1]) + (a[2] + a[3]);
  t += __shfl_xor(t, 16); t += __shfl_xor(t, 32);
  return rsqrtf(t * (1.0f / 1024.0f) + EPS); }
DI float row_rs_lds(const LAS unsigned char* lds, int rl, int fq) {
  const f32x4 a = *(const LAS f32x4*)(lds + LDS_RSB + rl * 64 + fq * 16);
  float t = (a[0] + a[1]) + (a[2] + a[3]);
  t += __shfl_xor(t, 16); t += __shfl_xor(t, 32);
  return rsqrtf(t * (1.0f / 1024.0f) + EPS); }
DI f32x4 mfma16(bf16x8 a, bf16x8 b, f32x4 c) { return __builtin_amdgcn_mfma_f32_16x16x32_bf16(a, b, c, 0, 0, 0); }

DI void lds_barrier() { asm volatile("s_waitcnt lgkmcnt(0)" ::: "memory"); __builtin_amdgcn_s_barrier(); asm volatile("" ::: "memory"); }
DI int opaque_tid() { int t = threadIdx.x; asm volatile("" : "+v"(t)); return t; }
constexpr int BM = 256, BK = 64, HALF = 128, HTB = HALF * BK * 2, NXCD = 8, WGM = 8;
DI int lds_byte(int r, int c) { const int st = (r >> 4) * 2 + (c >> 5), rr = r & 15, cc = c & 31, ob = rr * 64 + cc * 2; return st * 1024 + (ob ^ (((ob >> 9) & 1) << 5)); }
DI void stage_rc(int b, int& R, int& C) { const int st = b / 1024, sb = b % 1024, swz = sb ^ (((sb >> 9) & 1) << 5); R = (st >> 1) * 16 + swz / 64; C = (st & 1) * 32 + (swz % 64) / 2; }
DI int perm32(int rho) { const int n = rho >> 4, i = rho & 15; return 8 * (i >> 2) + 4 * n + (i & 3); }

struct GUnit { const char* A; const char* B; int lda2, ldb2, nt, pm, pn, mode; };

DI void tile_order(int L, int nM, int nN, int& pm, int& pn) {
  const int nwg = nM * nN; int wgid = L;
  { const int q = nwg / NXCD, r = nwg % NXCD, xcd = wgid % NXCD, off = wgid / NXCD; wgid = (xcd < r ? xcd * (q + 1) : r * (q + 1) + (xcd - r) * q) + off; }
  const int nig = WGM * nN, gid = wgid / nig, fm = gid * WGM, gsz = (nM - fm) < WGM ? (nM - fm) : WGM;
  pm = fm + ((wgid % nig) % gsz); pn = (wgid % nig) / gsz;
}

template <int RSMODE  , class Gen, class Epi>
DI void gemm_phase(LAS unsigned char* lds, const Gen& gen, const Epi& E, const float* ssqg) {
  const int tid = opaque_tid(), wid = __builtin_amdgcn_readfirstlane(tid >> 6), lane = tid & 63, wr = wid >> 2, wc = wid & 3, fr = lane & 15, fq = lane >> 4;
  int RA[2], RB[2], CC[2];
#pragma unroll
  for (int i = 0; i < 2; ++i) { int R, C; stage_rc(tid * 16 + i * 8192, R, C); RA[i] = R; RB[i] = (R & ~31) + perm32(R & 31); CC[i] = C * 2; }
  const unsigned ldsw = (unsigned)wid * 1024u;
  const int aoff = lds_byte(wr * 64 + fr, fq * 8), boff = lds_byte(wc * 32 + fr, fq * 8);
#define G_SA(b, h) (((b) * 2 + (h)) * HTB)
#define G_SB(b, h) ((4 + (b) * 2 + (h)) * HTB)
#define G_STAGEA(bufoff, gbase, ld2) do { _Pragma("unroll") for (int _i = 0; _i < 2; ++_i) \
    __builtin_amdgcn_global_load_lds((const unsigned*)((gbase) + (unsigned)(RA[_i] * (ld2) + CC[_i])), (LAS unsigned*)(lds + (bufoff) + ldsw + _i * 8192), 16, 0, 0); } while (0)
#define G_STAGEB(bufoff, gbase, ld2) do { _Pragma("unroll") for (int _i = 0; _i < 2; ++_i) \
    __builtin_amdgcn_global_load_lds((const unsigned*)((gbase) + (unsigned)(RB[_i] * (ld2) + CC[_i])), (LAS unsigned*)(lds + (bufoff) + ldsw + _i * 8192), 16, 0, 0); } while (0)
#define G_LDA(dst, b, h) do { _Pragma("unroll") for (int m = 0; m < 4; ++m) _Pragma("unroll") for (int k = 0; k < 2; ++k) dst[m][k] = *(const LAS bf16x8*)(lds + G_SA(b, h) + aoff + m * 2048 + k * 1024); } while (0)
#define G_LDB(dst, b, h) do { _Pragma("unroll") for (int n = 0; n < 2; ++n) _Pragma("unroll") for (int k = 0; k < 2; ++k) dst[n][k] = *(const LAS bf16x8*)(lds + G_SB(b, h) + boff + n * 2048 + k * 1024); } while (0)
#define G_MMA(ai, bj, At, Bt) do { __builtin_amdgcn_s_setprio(1); _Pragma("unroll") for (int m = 0; m < 4; ++m) _Pragma("unroll") for (int n = 0; n < 2; ++n) _Pragma("unroll") for (int k = 0; k < 2; ++k) \
    acc[ai][bj][m][n] = __builtin_amdgcn_mfma_f32_16x16x32_bf16(Bt[n][k], At[m][k], acc[ai][bj][m][n], 0, 0, 0); __builtin_amdgcn_s_setprio(0); } while (0)
#define G_WAIT_V(n) asm volatile("s_waitcnt vmcnt(" #n ")" ::: "memory")
#define G_WAIT_L(n) asm volatile("s_waitcnt lgkmcnt(" #n ")" ::: "memory")
#define G_BAR __builtin_amdgcn_s_barrier()
#define G_SCHED __builtin_amdgcn_sched_barrier(0)
  GUnit cur, nxt; int ui = 0;
  if (!gen.get(0, cur)) return;
  f32x4 acc[2][2][4][2];
#pragma unroll
  for (int a = 0; a < 2; ++a)
#pragma unroll
    for (int b = 0; b < 2; ++b)
#pragma unroll
      for (int m = 0; m < 4; ++m)
#pragma unroll
        for (int n = 0; n < 2; ++n) acc[a][b][m][n] = (f32x4){0.f, 0.f, 0.f, 0.f};
  bf16x8 At[4][2], B0[2][2], B1[2][2];
  const char* cA = cur.A; const char* cB = cur.B; int clda = cur.lda2, cldb = cur.ldb2;
  constexpr size_t kstep = BK * 2;
  G_STAGEB(G_SB(0, 0), cB, cldb); G_STAGEA(G_SA(0, 0), cA, clda); G_STAGEB(G_SB(0, 1), cB + (size_t)HALF * cldb, cldb); G_STAGEA(G_SA(0, 1), cA + (size_t)HALF * clda, clda);
  if (wr == 1) G_BAR;
  G_WAIT_V(4); G_BAR;
  G_STAGEB(G_SB(1, 0), cB + kstep, cldb); G_STAGEA(G_SA(1, 0), cA + kstep, clda); G_STAGEB(G_SB(1, 1), cB + (size_t)HALF * cldb + kstep, cldb);
  G_WAIT_V(6); G_BAR;
  for (;;) {
    const bool has_next = gen.get(ui + 1, nxt);
    const char* nA = has_next ? nxt.A : cA; const char* nB = has_next ? nxt.B : cB;
    const int nlda = has_next ? nxt.lda2 : clda, nldb = has_next ? nxt.ldb2 : cldb;
    const int nt = cur.nt;
    for (int t = 0; t < nt; t += 2) {
      const bool last = (t == nt - 2);
      const char* a1 = cA + (size_t)(t + 1) * kstep;
      const char* a2 = last ? nA : cA + (size_t)(t + 2) * kstep; const char* b2 = last ? nB : cB + (size_t)(t + 2) * kstep;
      const int lda_n = last ? nlda : clda, ldb_n = last ? nldb : cldb;
      const char* a3 = a2 + kstep; const char* b3 = b2 + kstep;
      G_LDB(B0, 0, 0); G_SCHED; G_LDA(At, 0, 0); G_STAGEA(G_SA(1, 1), a1 + (size_t)HALF * clda, clda);
      if (RSMODE != 0 && t == 2 && (RSMODE == 1 || cur.mode == 0)) {
        const char* rsrc = (const char*)ssqg + (size_t)cur.pm * (BM * 64) + ldsw + (unsigned)lane * 16u;
#pragma unroll
        for (int _i = 0; _i < 2; ++_i) __builtin_amdgcn_global_load_lds((const unsigned*)(rsrc + _i * 8192), (LAS unsigned*)(lds + LDS_RSB + ldsw + _i * 8192), 16, 0, 0);
      }
      G_WAIT_L(8); G_BAR; G_WAIT_L(0); G_MMA(0, 0, At, B0); G_BAR; G_SCHED;
      G_LDB(B1, 0, 1); G_STAGEB(G_SB(0, 0), b2, ldb_n);
      G_BAR; G_WAIT_L(0); G_MMA(0, 1, At, B1); G_BAR;
      G_LDA(At, 0, 1); G_STAGEA(G_SA(0, 0), a2, lda_n);
      G_BAR; G_WAIT_L(0); G_MMA(1, 0, At, B0); G_BAR; G_SCHED;
      G_STAGEB(G_SB(0, 1), b2 + (size_t)HALF * ldb_n, ldb_n);
      G_WAIT_V(6); G_BAR; G_MMA(1, 1, At, B1); G_BAR;
      G_LDB(B0, 1, 0); G_SCHED; G_LDA(At, 1, 0); G_STAGEA(G_SA(0, 1), a2 + (size_t)HALF * lda_n, lda_n);
      G_WAIT_L(8); G_BAR; G_WAIT_L(0); G_MMA(0, 0, At, B0); G_BAR; G_SCHED;
      G_LDB(B1, 1, 1); G_STAGEB(G_SB(1, 0), b3, ldb_n);
      G_BAR; G_WAIT_L(0); G_MMA(0, 1, At, B1); G_BAR;
      G_LDA(At, 1, 1); G_STAGEA(G_SA(1, 0), a3, lda_n);
      G_BAR; G_WAIT_L(0); G_MMA(1, 0, At, B0); G_BAR; G_SCHED;
      G_STAGEB(G_SB(1, 1), b3 + (size_t)HALF * ldb_n, ldb_n);
      G_WAIT_V(6); G_BAR; G_MMA(1, 1, At, B1); G_BAR;
    }
    E(acc, cur, wr, wc, fr, fq, lds);
    if (!has_next) break;
#pragma unroll
    for (int a = 0; a < 2; ++a)
#pragma unroll
      for (int b = 0; b < 2; ++b)
#pragma unroll
        for (int m = 0; m < 4; ++m)
#pragma unroll
          for (int n = 0; n < 2; ++n) acc[a][b][m][n] = (f32x4){0.f, 0.f, 0.f, 0.f};
    cur = nxt; cA = nA; cB = nB; clda = nlda; cldb = nldb; ++ui;
  }
  G_WAIT_V(0);
  if (wr == 0) G_BAR;
  G_BAR;
#undef G_SA
#undef G_SB
#undef G_STAGEA
#undef G_STAGEB
#undef G_LDA
#undef G_LDB
#undef G_MMA
}

struct GenPlain {
  const char* A; const char* B; int lda2, ldb2, nt, nM, nN, G, c;
  DI bool get(int i, GUnit& u) const {
    const long L = (long)i * G + c; if (L >= (long)nM * nN) return false;
    int pm, pn; tile_order((int)L, nM, nN, pm, pn);
    u.A = A + (size_t)pm * BM * lda2; u.B = B + (size_t)pn * BM * ldb2; u.lda2 = lda2; u.ldb2 = ldb2; u.nt = nt; u.pm = pm; u.pn = pn; u.mode = 0; return true;
  }
};
struct GenMerge {
  const char* xb; const char* proj; const char* wg; const char* wbr; int G, c;
  DI bool get(int i, GUnit& u) const {
    const int ti = i / 6, sub = i - ti * 6, br = sub >> 1;
    const long L = (long)ti * G + c; if (L >= 512) return false;
    int pm, pn; tile_order((int)L, 128, 4, pm, pn);
    u.pm = pm; u.pn = pn;
    if ((sub & 1) == 0) { u.A = xb + (size_t)pm * BM * 2048; u.lda2 = 2048; u.B = wg + ((size_t)br * 1024 + (size_t)pn * BM) * 2048; u.ldb2 = 2048; u.nt = 16; u.mode = 0; }
    else { const int col = br == 0 ? C_QA : (br == 1 ? C_UB : C_QC);
      u.A = proj + (size_t)pm * BM * (NP * 2) + (size_t)col * 2; u.lda2 = NP * 2; u.B = wbr + ((size_t)br * 1024 + (size_t)pn * BM) * 1024; u.ldb2 = 1024; u.nt = 8; u.mode = br + 1; }
    return true;
  }
};

struct EpiProj {
  bf16_t* P; const float* ssq; const float* lb;
  DI void operator()(const f32x4 (&acc)[2][2][4][2], const GUnit& u, int wr, int wc, int fr, int fq, const LAS unsigned char* lds) const {
    const int row0 = u.pm * BM + wr * 64 + fr;
    float rs[2][4];
#pragma unroll
    for (int ai = 0; ai < 2; ++ai)
#pragma unroll
      for (int m = 0; m < 4; ++m) rs[ai][m] = row_rs_lds(lds, wr * 64 + fr + ai * HALF + m * 16, fq);
#pragma unroll
    for (int bj = 0; bj < 2; ++bj) {
      const int cb = u.pn * BM + bj * HALF; const int region = cb >> 9;
      const int col0 = cb + wc * 32 + 8 * fq;
      int act = 0;
      if (region == 2 || region == 3) act = 3;
      float lbv[8];
      if (act == 3) { const f32x4 l0 = *(const f32x4*)(lb + col0 - 1024), l1 = *(const f32x4*)(lb + col0 - 1024 + 4);
#pragma unroll
        for (int j = 0; j < 4; ++j) { lbv[j] = l0[j]; lbv[4 + j] = l1[j]; } }
#pragma unroll
      for (int ai = 0; ai < 2; ++ai)
#pragma unroll
        for (int m = 0; m < 4; ++m) {
          float v[8];
#pragma unroll
          for (int j = 0; j < 4; ++j) { v[j] = acc[ai][bj][m][0][j] * rs[ai][m]; v[4 + j] = acc[ai][bj][m][1][j] * rs[ai][m]; }
          u32x4 w;
          if (act == 3) {
            unsigned short hh[8];
#pragma unroll
            for (int j = 0; j < 8; ++j) { const float f = lbv[j] + (1.0f - lbv[j]) * fsigmoid(v[j]); hh[j] = f2h(fmaxf(__builtin_amdgcn_logf(f), -43.0f)); }
            w.x = hh[0] | ((unsigned)hh[1] << 16); w.y = hh[2] | ((unsigned)hh[3] << 16); w.z = hh[4] | ((unsigned)hh[5] << 16); w.w = hh[6] | ((unsigned)hh[7] << 16);
          } else {
            if (act == 1) {
#pragma unroll
              for (int j = 0; j < 8; ++j) v[j] = fsilu(v[j]);
            } else if (act == 2) {
#pragma unroll
              for (int j = 0; j < 8; ++j) v[j] = fgelu(v[j]);
            }
            w.x = pk_bf16(v[0], v[1]); w.y = pk_bf16(v[2], v[3]); w.z = pk_bf16(v[4], v[5]); w.w = pk_bf16(v[6], v[7]);
          }
          *(u32x4*)(P + (size_t)(row0 + ai * HALF + m * 16) * NP + col0) = w;
          asm volatile("" ::: "memory");
        }
    }
  }
};
struct EpiMerge {
  bf16_t* P; const float* ssq; unsigned char* scr;
  template <int MODE>
  DI void run(const f32x4 (&acc)[2][2][4][2], const GUnit& u, int wr, int wc, int fr, int fq, const LAS unsigned char* lds) const {
    const int row0 = u.pm * BM + wr * 64 + fr;
    unsigned voff = (unsigned)((wr * 4 + wc) * 64 + fq * 16 + fr) * 8u; asm volatile("" : "+v"(voff));
#pragma unroll
    for (int ai = 0; ai < 2; ++ai) {
      u32x2 g[4][2]; u32x4 mm[4][2];
      if (MODE >= 1) {
#pragma unroll
        for (int m = 0; m < 4; ++m)
#pragma unroll
          for (int bj = 0; bj < 2; ++bj) { const int q = (ai * 4 + m) * 2 + bj;
            g[m][bj] = *(const u32x2*)((scr + 131072 + q * 4096) + voff);
            if (MODE >= 2) mm[m][bj] = *(const u32x4*)((scr + q * 8192) + voff * 2u); }
      }
#pragma unroll
      for (int m = 0; m < 4; ++m) {
        const int r = row0 + ai * HALF + m * 16;
        float rsv = 0.f; if (MODE == 0) rsv = row_rs_lds(lds, wr * 64 + fr + ai * HALF + m * 16, fq) * -1.4426950408889634f;
#pragma unroll
        for (int bj = 0; bj < 2; ++bj) {
          const int q = (ai * 4 + m) * 2 + bj;
          u32x2* gp = (u32x2*)((scr + 131072 + q * 4096) + voff); u32x4* mp = (u32x4*)((scr + q * 8192) + voff * 2u);
          if (MODE == 0) {
            u32x2 w = {0u, 0u};
#pragma unroll
            for (int j = 0; j < 4; ++j) {
              w.x = __builtin_amdgcn_cvt_pk_u8_f32(__builtin_amdgcn_rcpf(__builtin_fmaf(__builtin_amdgcn_exp2f(acc[ai][bj][m][0][j] * rsv), 1.0f / 255.0f, 1.0f / 255.0f)), j, w.x);
              w.y = __builtin_amdgcn_cvt_pk_u8_f32(__builtin_amdgcn_rcpf(__builtin_fmaf(__builtin_amdgcn_exp2f(acc[ai][bj][m][1][j] * rsv), 1.0f / 255.0f, 1.0f / 255.0f)), j, w.y); }
            *gp = w;
          } else {
            const u32x2 gg = g[m][bj];
            float v[8];
#pragma unroll
            for (int j = 0; j < 4; ++j) { v[j] = acc[ai][bj][m][0][j] * (float)((gg.x >> (8 * j)) & 0xffu); v[4 + j] = acc[ai][bj][m][1][j] * (float)((gg.y >> (8 * j)) & 0xffu); }
            if (MODE >= 2) { const u32x4 mv = mm[m][bj];
              v[0] += bflo(mv.x); v[1] += bfhi(mv.x); v[2] += bflo(mv.y); v[3] += bfhi(mv.y); v[4] += bflo(mv.z); v[5] += bfhi(mv.z); v[6] += bflo(mv.w); v[7] += bfhi(mv.w); }
            u32x4 w; w.x = pk_bf16(v[0], v[1]); w.y = pk_bf16(v[2], v[3]); w.z = pk_bf16(v[4], v[5]); w.w = pk_bf16(v[6], v[7]);
            if (MODE == 3) *(u32x4*)(P + (size_t)r * NP + C_MERGED + u.pn * BM + bj * HALF + wc * 32 + 8 * fq) = w;
            else *mp = w;
          }
        }
      }
      asm volatile("" ::: "memory");
    }
  }
  DI void operator()(const f32x4 (&acc)[2][2][4][2], const GUnit& u, int wr, int wc, int fr, int fq, const LAS unsigned char* lds) const {
    if (u.mode == 0) run<0>(acc, u, wr, wc, fr, fq, lds); else if (u.mode == 1) run<1>(acc, u, wr, wc, fr, fq, lds); else if (u.mode == 2) run<2>(acc, u, wr, wc, fr, fq, lds); else run<3>(acc, u, wr, wc, fr, fq, lds);
  }
};
struct EpiOut {
  const float* XI; float* XO; bf16_t* XB; float* ssqn; int first, lastl;
  DI void operator()(const f32x4 (&acc)[2][2][4][2], const GUnit& u, int wr, int wc, int fr, int fq, const LAS unsigned char*) const {
    const int row0 = u.pm * BM + wr * 64 + fr;
#pragma unroll
    for (int ai = 0; ai < 2; ++ai)
#pragma unroll
      for (int mh = 0; mh < 2; ++mh) {
        f32x4 xa[2][2], xb2[2][2];
        if (first) {
#pragma unroll
          for (int mm = 0; mm < 2; ++mm)
#pragma unroll
            for (int bj = 0; bj < 2; ++bj) { const float* xi = XI + (size_t)(row0 + ai * HALF + (mh * 2 + mm) * 16) * DM + u.pn * BM + bj * HALF + wc * 32 + 8 * fq; xa[mm][bj] = *(const f32x4*)xi; xb2[mm][bj] = *(const f32x4*)(xi + 4); }
        } else {
          u32x4 xw[2][2];
#pragma unroll
          for (int mm = 0; mm < 2; ++mm)
#pragma unroll
            for (int bj = 0; bj < 2; ++bj) xw[mm][bj] = *(const u32x4*)(XB + (size_t)(row0 + ai * HALF + (mh * 2 + mm) * 16) * DM + u.pn * BM + bj * HALF + wc * 32 + 8 * fq);
#pragma unroll
          for (int mm = 0; mm < 2; ++mm)
#pragma unroll
            for (int bj = 0; bj < 2; ++bj) { xa[mm][bj] = (f32x4){bflo(xw[mm][bj].x), bfhi(xw[mm][bj].x), bflo(xw[mm][bj].y), bfhi(xw[mm][bj].y)}; xb2[mm][bj] = (f32x4){bflo(xw[mm][bj].z), bfhi(xw[mm][bj].z), bflo(xw[mm][bj].w), bfhi(xw[mm][bj].w)}; }
        }
#pragma unroll
        for (int mm = 0; mm < 2; ++mm) {
          const int m = mh * 2 + mm;
          const int r = row0 + ai * HALF + m * 16; float ss = 0.f;
#pragma unroll
          for (int bj = 0; bj < 2; ++bj) {
            const int col0 = u.pn * BM + bj * HALF + wc * 32 + 8 * fq;
            f32x4 x0 = xa[mm][bj] + acc[ai][bj][m][0], x1 = xb2[mm][bj] + acc[ai][bj][m][1];
            if (lastl) { float* xp = XO + (size_t)r * DM + col0; *(f32x4*)xp = x0; *(f32x4*)(xp + 4) = x1; }
            else {
              u32x4 w; w.x = pk_bf16(x0[0], x0[1]); w.y = pk_bf16(x0[2], x0[3]); w.z = pk_bf16(x1[0], x1[1]); w.w = pk_bf16(x1[2], x1[3]);
              *(u32x4*)(XB + (size_t)r * DM + col0) = w;
              ss += (x0[0] * x0[0] + x0[1] * x0[1]) + (x0[2] * x0[2] + x0[3] * x0[3]) + (x1[0] * x1[0] + x1[1] * x1[1]) + (x1[2] * x1[2] + x1[3] * x1[3]);
            }
          }
          if (!lastl) { ss += __shfl_xor(ss, 16); ss += __shfl_xor(ss, 32);
            if (fq == 0) ssqn[(size_t)r * 16 + u.pn * 4 + wc] = ss; }
        }
        asm volatile("" ::: "memory");
      }
  }
};

DI int inproj_orig_col(int n) {
  const int mb = n >> 7, w = n & 127; int ob;
  if (mb < 4) ob = mb; else if (mb < 8) ob = mb + 8; else if (mb < 16) ob = mb - 4; else if (mb < 24) ob = mb;
  else if (mb < 28) ob = mb + 4; else if (mb < 32) ob = mb - 4; else if (mb < 36) ob = mb; else if (mb < 40) ob = mb + 2; else ob = mb - 4;
  return ob * 128 + w;
}
DI void convert_w(const float* W, int ldw, int K, bf16_t* Wt, int Nn, int mapmode, int colbase, const float* gain, long gtid, long gthreads, float scale = 1.0f) {
  const long ntask = (long)Nn * (K / 8);
  for (long task0 = gtid; task0 < ntask; task0 += 2 * gthreads) {
    float v[2][8]; int k8s[2], ns[2]; bool ok[2];
#pragma unroll
    for (int u = 0; u < 2; ++u) {
      const long task = task0 + u * gthreads; ok[u] = task < ntask; const long tk = ok[u] ? task : task0;
      const int k8 = (int)(tk / Nn), n = (int)(tk - (long)k8 * Nn); k8s[u] = k8; ns[u] = n;
      const int oc = mapmode ? inproj_orig_col(n) : colbase + n;
#pragma unroll
      for (int i = 0; i < 8; ++i) v[u][i] = W[(size_t)(k8 * 8 + i) * ldw + oc];
    }
#pragma unroll
    for (int u = 0; u < 2; ++u) {
      const int k8 = k8s[u], n = ns[u];
      if (gain) { const f32x4 g0 = *(const f32x4*)(gain + k8 * 8), g1 = *(const f32x4*)(gain + k8 * 8 + 4);
#pragma unroll
        for (int i = 0; i < 4; ++i) { v[u][i] *= g0[i]; v[u][4 + i] *= g1[i]; } }
      u32x4 w; w.x = pk_bf16(v[u][0] * scale, v[u][1] * scale); w.y = pk_bf16(v[u][2] * scale, v[u][3] * scale); w.z = pk_bf16(v[u][4] * scale, v[u][5] * scale); w.w = pk_bf16(v[u][6] * scale, v[u][7] * scale);
      if (ok[u]) *(u32x4*)(Wt + (size_t)n * K + k8 * 8) = w;
    }
  }
}

typedef short s16x4 __attribute__((ext_vector_type(4)));
DI bf16x8 tr_pair(const LAS bf16_t* p0, const LAS bf16_t* p1) {
  const s16x4 a = __builtin_amdgcn_ds_read_tr16_b64_v4i16((LAS s16x4*)p0), b = __builtin_amdgcn_ds_read_tr16_b64_v4i16((LAS s16x4*)p1);
  return (bf16x8){a[0], a[1], a[2], a[3], b[0], b[1], b[2], b[3]};
}
constexpr int SG_LD = 528;
DI void sgu_item(LAS unsigned char* lds, const Params& p, int l, int item) {
  bf16_t* P = (bf16_t*)(p.ws + WS_PROJ);
  const int tid = opaque_tid(), wid = __builtin_amdgcn_readfirstlane(tid >> 6), lane = tid & 63, fr = lane & 15, fq = lane >> 4;
  const size_t tok0 = (size_t)item * 128;
  LAS bf16_t* vn = (LAS bf16_t*)lds;
  __syncthreads();
  {
    const float* lng = p.sg_g + l * 512 + lane * 8; const float* lnb = p.sg_b + l * 512 + lane * 8;
    const f32x4 g0 = *(const f32x4*)lng, g1 = *(const f32x4*)(lng + 4), b0 = *(const f32x4*)lnb, b1 = *(const f32x4*)(lnb + 4);
    u32x4 w[16];
#pragma unroll
    for (int i = 0; i < 16; ++i) w[i] = *(const u32x4*)(P + (tok0 + wid * 16 + i) * NP + C_VB + lane * 8);
#pragma unroll
    for (int i = 0; i < 16; ++i) {
      float v[8] = {fgelu(bflo(w[i].x)), fgelu(bfhi(w[i].x)), fgelu(bflo(w[i].y)), fgelu(bfhi(w[i].y)), fgelu(bflo(w[i].z)), fgelu(bfhi(w[i].z)), fgelu(bflo(w[i].w)), fgelu(bfhi(w[i].w))};
      float sm = 0.f;
#pragma unroll
      for (int j = 0; j < 8; ++j) sm += v[j];
#pragma unroll
      for (int o = 32; o >= 1; o >>= 1) sm += __shfl_xor(sm, o);
      const float mu = sm * (1.0f / 512.0f); float q = 0.f;
#pragma unroll
      for (int j = 0; j < 8; ++j) { v[j] -= mu; q += v[j] * v[j]; }
#pragma unroll
      for (int o = 32; o >= 1; o >>= 1) q += __shfl_xor(q, o);
      const float rstd = rsqrtf(q * (1.0f / 512.0f) + EPS);
      u32x4 r;
      r.x = pk_bf16(v[0] * rstd * g0[0] + b0[0], v[1] * rstd * g0[1] + b0[1]); r.y = pk_bf16(v[2] * rstd * g0[2] + b0[2], v[3] * rstd * g0[3] + b0[3]);
      r.z = pk_bf16(v[4] * rstd * g1[0] + b1[0], v[5] * rstd * g1[1] + b1[1]); r.w = pk_bf16(v[6] * rstd * g1[2] + b1[2], v[7] * rstd * g1[3] + b1[3]);
      *(LAS u32x4*)(vn + (wid * 16 + i) * SG_LD + lane * 8) = r;
    }
  }
  __syncthreads();
  const int t = wid * 16 + fr;
#pragma unroll 1
  for (int g = 0; g < 4; ++g) {
    const float* wrow = p.w_sp + (((size_t)l * 4 + g) * 128 + t) * 128;
    bf16x8 bfrag[4];
    f32x4 wa[4], wb[4];
#pragma unroll
    for (int kk = 0; kk < 4; ++kk) { wa[kk] = *(const f32x4*)(wrow + kk * 32 + fq * 4); wb[kk] = *(const f32x4*)(wrow + kk * 32 + 16 + fq * 4); }
    const float bias = p.b_sp[((size_t)l * 4 + g) * 128 + t];
    u32x2 uu[8], zz[8];
#pragma unroll
    for (int ct = 0; ct < 8; ++ct) { const size_t off = (tok0 + t) * NP + g * 128 + ct * 16 + fq * 4; uu[ct] = *(const u32x2*)(P + off + C_UB); zz[ct] = *(const u32x2*)(P + off + C_ZB); }
    asm volatile("" ::: "memory");
#pragma unroll
    for (int kk = 0; kk < 4; ++kk) { u32x4 w; w.x = pk_bf16(wa[kk][0], wa[kk][1]); w.y = pk_bf16(wa[kk][2], wa[kk][3]); w.z = pk_bf16(wb[kk][0], wb[kk][1]); w.w = pk_bf16(wb[kk][2], wb[kk][3]); bfrag[kk] = __builtin_bit_cast(bf16x8, w); }
#pragma unroll
    for (int ct = 0; ct < 8; ++ct) {
      f32x4 acc = {0.f, 0.f, 0.f, 0.f};
#pragma unroll
      for (int kk = 0; kk < 4; ++kk) {
        const LAS bf16_t* base = vn + (kk * 32 + fq * 4 + (fr >> 2)) * SG_LD + g * 128 + ct * 16 + (fr & 3) * 4;
        const bf16x8 a = tr_pair(base, base + 16 * SG_LD);
        acc = mfma16(a, bfrag[kk], acc);
      }
      const size_t off = (tok0 + t) * NP + g * 128 + ct * 16 + fq * 4;
      const float o0 = fgelu(bflo(uu[ct].x)) * (acc[0] + bias) * fsilu(bflo(zz[ct].x)), o1 = fgelu(bfhi(uu[ct].x)) * (acc[1] + bias) * fsilu(bfhi(zz[ct].x));
      const float o2 = fgelu(bflo(uu[ct].y)) * (acc[2] + bias) * fsilu(bflo(zz[ct].y)), o3 = fgelu(bfhi(uu[ct].y)) * (acc[3] + bias) * fsilu(bfhi(zz[ct].y));
      u32x2 w; w.x = pk_bf16(o0, o1); w.y = pk_bf16(o2, o3);
      *(u32x2*)(P + off + C_UB) = w;
    }
  }
  __syncthreads();
}

constexpr int AT_KLD = 80;
constexpr int AT_VLD = 80;
DI void rope8(const float (&x1)[8], const float (&x2)[8], float rstd, const float* g1, const float* g2, const float* cs, u32x4& o0, u32x4& o1) {
  const f32x4 c0 = *(const f32x4*)cs, c1 = *(const f32x4*)(cs + 4), s0 = *(const f32x4*)(cs + 32), s1 = *(const f32x4*)(cs + 36);
  const f32x4 ga0 = *(const f32x4*)g1, ga1 = *(const f32x4*)(g1 + 4), gb0 = *(const f32x4*)g2, gb1 = *(const f32x4*)(g2 + 4);
  float y1[8], y2[8];
#pragma unroll
  for (int j = 0; j < 8; ++j) {
    const float c = j < 4 ? c0[j & 3] : c1[j & 3], sn = j < 4 ? s0[j & 3] : s1[j & 3];
    const float a = x1[j] * rstd * (j < 4 ? ga0[j & 3] : ga1[j & 3]), bb = x2[j] * rstd * (j < 4 ? gb0[j & 3] : gb1[j & 3]);
    y1[j] = a * c - bb * sn; y2[j] = bb * c + a * sn;
  }
  o0.x = pk_bf16(y1[0], y1[1]); o0.y = pk_bf16(y1[2], y1[3]); o0.z = pk_bf16(y1[4], y1[5]); o0.w = pk_bf16(y1[6], y1[7]);
  o1.x = pk_bf16(y2[0], y2[1]); o1.y = pk_bf16(y2[2], y2[3]); o1.z = pk_bf16(y2[4], y2[5]); o1.w = pk_bf16(y2[6], y2[7]);
}
DI void attn_item(LAS unsigned char* lds, const Params& p, int l, int item) {
  bf16_t* P = (bf16_t*)(p.ws + WS_PROJ);
  const float* ropec = (const float*)(p.ws + WS_ROPE);
  const int tid = opaque_tid(), wid = __builtin_amdgcn_readfirstlane(tid >> 6), lane = tid & 63, fr = lane & 15, fq = lane >> 4;
  const int blk = item & 63, kvh = (item >> 6) & 1, b = item >> 7;
  const size_t tokb = (size_t)b * SEQ;
  LAS bf16_t* Ks = (LAS bf16_t*)lds;
  LAS bf16_t* Vs = (LAS bf16_t*)(lds + 384 * AT_KLD * 2);
  const float* qg = p.qg + l * 64; const float* kg = p.kg + l * 64;
  __syncthreads();
  {
    u32x4 w[6];
#pragma unroll
    for (int it = 0; it < 6; ++it) { const int task = it * 512 + tid; const int kk = task >> 3, o8 = task & 7; const int pos = blk * 128 - 128 + kk;
      const int pc = pos < 0 ? 0 : (pos >= SEQ ? SEQ - 1 : pos);
      w[it] = *(const u32x4*)(P + (tokb + pc) * NP + C_VC + kvh * 64 + o8 * 8); }
#pragma unroll
    for (int it = 0; it < 6; ++it) { const int task = it * 512 + tid; const int kk = task >> 3, o8 = task & 7; *(LAS u32x4*)(Vs + kk * AT_VLD + o8 * 8) = w[it]; }
  }
  {
    u32x4 w0[3], w1[3];
#pragma unroll
    for (int it = 0; it < 3; ++it) { const int task = it * 512 + tid; const int kk = task >> 2, o = task & 3; const int pos = blk * 128 - 128 + kk;
      const int pc = pos < 0 ? 0 : (pos >= SEQ ? SEQ - 1 : pos);
      const bf16_t* src = P + (tokb + pc) * NP + C_KC + kvh * 64 + o * 8; w0[it] = *(const u32x4*)src; w1[it] = *(const u32x4*)(src + 32); }
#pragma unroll
    for (int it = 0; it < 3; ++it) { const int task = it * 512 + tid; const int kk = task >> 2, o = task & 3; const int pos = blk * 128 - 128 + kk;
      const float x1[8] = {bflo(w0[it].x), bfhi(w0[it].x), bflo(w0[it].y), bfhi(w0[it].y), bflo(w0[it].z), bfhi(w0[it].z), bflo(w0[it].w), bfhi(w0[it].w)};
      const float x2[8] = {bflo(w1[it].x), bfhi(w1[it].x), bflo(w1[it].y), bfhi(w1[it].y), bflo(w1[it].z), bfhi(w1[it].z), bflo(w1[it].w), bfhi(w1[it].w)};
      float ss = 0.f;
#pragma unroll
      for (int j = 0; j < 8; ++j) ss += x1[j] * x1[j] + x2[j] * x2[j];
      ss += __shfl_xor(ss, 1); ss += __shfl_xor(ss, 2);
      const float rstd = rsqrtf(ss * (1.0f / 64.0f) + EPS);
      const int pc = pos < 0 ? 0 : (pos >= SEQ ? SEQ - 1 : pos);
      u32x4 o0, o1; rope8(x1, x2, rstd, kg + o * 8, kg + 32 + o * 8, ropec + (size_t)pc * 64 + o * 8, o0, o1);
      *(LAS u32x4*)(Ks + kk * AT_KLD + o * 8) = o0; *(LAS u32x4*)(Ks + kk * AT_KLD + 32 + o * 8) = o1; }
  }
  float gq = fabsf(qg[lane]), gk = fabsf(kg[lane]);
#pragma unroll
  for (int o = 32; o >= 1; o >>= 1) { gq = fmaxf(gq, __shfl_xor(gq, o)); gk = fmaxf(gk, __shfl_xor(gk, o)); }
  const int hq = kvh * 4 + (wid & 3), half = wid >> 2;
  const float sinkv = p.sink[l * 8 + hq];
  const float mshift = fmaxf(8.0f * gq * gk, sinkv) * 1.4426950408889634f;
  bf16x8 qf[4][2];
  {
    u32x4 w0[4], w1[4];
#pragma unroll
    for (int qt = 0; qt < 4; ++qt) { const int pos = blk * 128 + half * 64 + qt * 16 + fr; const bf16_t* src = P + (tokb + pos) * NP + C_QC + hq * 64 + fq * 8; w0[qt] = *(const u32x4*)src; w1[qt] = *(const u32x4*)(src + 32); }
#pragma unroll
    for (int qt = 0; qt < 4; ++qt) {
      const int pos = blk * 128 + half * 64 + qt * 16 + fr;
      const float x1[8] = {bflo(w0[qt].x), bfhi(w0[qt].x), bflo(w0[qt].y), bfhi(w0[qt].y), bflo(w0[qt].z), bfhi(w0[qt].z), bflo(w0[qt].w), bfhi(w0[qt].w)};
      const float x2[8] = {bflo(w1[qt].x), bfhi(w1[qt].x), bflo(w1[qt].y), bfhi(w1[qt].y), bflo(w1[qt].z), bfhi(w1[qt].z), bflo(w1[qt].w), bfhi(w1[qt].w)};
      float ss = 0.f;
#pragma unroll
      for (int j = 0; j < 8; ++j) ss += x1[j] * x1[j] + x2[j] * x2[j];
      ss += __shfl_xor(ss, 16); ss += __shfl_xor(ss, 32);
      const float rstd = rsqrtf(ss * (1.0f / 64.0f) + EPS) * (0.125f * 1.4426950408889634f);
      u32x4 o0, o1; rope8(x1, x2, rstd, qg + fq * 8, qg + 32 + fq * 8, ropec + (size_t)pos * 64 + fq * 8, o0, o1);
      qf[qt][0] = __builtin_bit_cast(bf16x8, o0); qf[qt][1] = __builtin_bit_cast(bf16x8, o1);
    }
  }
  __syncthreads();
  f32x4 oacc[4][4];
  float lsum[4] = {0.f, 0.f, 0.f, 0.f};
#pragma unroll
  for (int a = 0; a < 4; ++a)
#pragma unroll
    for (int c = 0; c < 4; ++c) oacc[a][c] = (f32x4){0.f, 0.f, 0.f, 0.f};
  const int qs = half * 64;
  for (int kp = 0; kp < 12; ++kp) {
    const int k0 = kp * 32 - 128;
    if (k0 + 31 < qs - 128 || k0 > qs + 63 + 128) continue;
    const int kabs0 = blk * 128 + k0;
    if (kabs0 + 31 < 0 || kabs0 >= SEQ) continue;
    bf16x8 kf[2][2];
#pragma unroll
    for (int kt = 0; kt < 2; ++kt)
#pragma unroll
      for (int hh = 0; hh < 2; ++hh) kf[kt][hh] = *(const LAS bf16x8*)(Ks + (kp * 32 + kt * 16 + fr) * AT_KLD + hh * 32 + fq * 8);
    bf16x8 vf[4];
#pragma unroll
    for (int dt = 0; dt < 4; ++dt) { const LAS bf16_t* base = Vs + (kp * 32 + fq * 4 + (fr >> 2)) * AT_VLD + dt * 16 + (fr & 3) * 4; vf[dt] = tr_pair(base, base + 16 * AT_VLD); }
#pragma unroll
    for (int qt = 0; qt < 4; ++qt) {
      const int q0 = qs + qt * 16;
      const bool interior = (k0 + 31 - q0 <= 128) && (q0 + 15 - k0 <= 128) && (kabs0 >= 0) && (kabs0 + 31 < SEQ);
      const int qrel = q0 + fr;
      float pv[8];
#pragma unroll
      for (int kt = 0; kt < 2; ++kt) {
        f32x4 sc = {-mshift, -mshift, -mshift, -mshift};
        sc = mfma16(kf[kt][0], qf[qt][0], sc); sc = mfma16(kf[kt][1], qf[qt][1], sc);
        if (interior) {
#pragma unroll
          for (int j = 0; j < 4; ++j) { const float e = __builtin_amdgcn_exp2f(sc[j]); pv[kt * 4 + j] = e; lsum[qt] += e; }
        } else {
#pragma unroll
          for (int j = 0; j < 4; ++j) {
            const int krel = k0 + kt * 16 + fq * 4 + j; const int kab = blk * 128 + krel; const int d = krel - qrel;
            const bool ok = (d <= 128) && (d >= -128) && (kab >= 0) && (kab < SEQ);
            const float e = ok ? __builtin_amdgcn_exp2f(sc[j]) : 0.f;
            pv[kt * 4 + j] = e; lsum[qt] += e;
          }
        }
      }
      u32x4 pw; pw.x = pk_bf16(pv[0], pv[1]); pw.y = pk_bf16(pv[2], pv[3]); pw.z = pk_bf16(pv[4], pv[5]); pw.w = pk_bf16(pv[6], pv[7]);
      const bf16x8 pb = __builtin_bit_cast(bf16x8, pw);
#pragma unroll
      for (int dt = 0; dt < 4; ++dt) oacc[dt][qt] = mfma16(vf[dt], pb, oacc[dt][qt]);
    }
  }
  const float esink = __builtin_amdgcn_exp2f(sinkv * 1.4426950408889634f - mshift);
  u32x2 zz[4][4];
#pragma unroll
  for (int qt = 0; qt < 4; ++qt)
#pragma unroll
    for (int dt = 0; dt < 4; ++dt) { const int pos = blk * 128 + half * 64 + qt * 16 + fr; zz[qt][dt] = *(const u32x2*)(P + (tokb + pos) * NP + hq * 64 + dt * 16 + fq * 4 + C_ZC); }
#pragma unroll
  for (int qt = 0; qt < 4; ++qt) {
    float ls = lsum[qt]; ls += __shfl_xor(ls, 16); ls += __shfl_xor(ls, 32);
    const float inv = 1.0f / (ls + esink);
    const int pos = blk * 128 + half * 64 + qt * 16 + fr;
#pragma unroll
    for (int dt = 0; dt < 4; ++dt) {
      const size_t off = (tokb + pos) * NP + hq * 64 + dt * 16 + fq * 4;
      const u32x2 z = zz[qt][dt];
      u32x2 w; w.x = pk_bf16(oacc[dt][qt][0] * inv * fsilu(bflo(z.x)), oacc[dt][qt][1] * inv * fsilu(bfhi(z.x))); w.y = pk_bf16(oacc[dt][qt][2] * inv * fsilu(bflo(z.y)), oacc[dt][qt][3] * inv * fsilu(bfhi(z.y)));
      *(u32x2*)(P + off + C_QC) = w;
    }
  }
}

constexpr int SCR = 512, NSC = SEQ / SCR, NSUB = SCR / 64;
constexpr int H_QLD = 144, H_TLD = 80;
constexpr int H_QS = 0, H_KS = H_QS + 64 * H_QLD * 2, H_KT = H_KS + 64 * H_QLD * 2, H_VT = H_KT + 128 * H_TLD * 2, H_ST = H_VT + 128 * H_TLD * 2,
              H_SEG = H_ST + 128 * H_QLD * 2, H_SSQ = H_SEG + 2 * 4 * 128 * 4, H_GN = H_SSQ + 2 * 64 * 4, H_END = H_GN + 128 * 4;
static_assert(H_END <= LDS_BYTES, "hgrn lds");

template <bool OUT>
DI void hgrn_super(LAS unsigned char* lds, const Params& p, int l, int b, int h, int nn, int dir, f32x4 (&S)[8], float& btot) {
  bf16_t* P = (bf16_t*)(p.ws + WS_PROJ);
  const int tid = opaque_tid(), wid = __builtin_amdgcn_readfirstlane(tid >> 6), lane = tid & 63, fr = lane & 15, fq = lane >> 4;
  const int d = tid & 127, seg = tid >> 7;
  LAS bf16_t* Qs = (LAS bf16_t*)(lds + H_QS); LAS bf16_t* Ks = (LAS bf16_t*)(lds + H_KS); LAS bf16_t* KT = (LAS bf16_t*)(lds + H_KT);
  LAS bf16_t* Vt = (LAS bf16_t*)(lds + H_VT); LAS bf16_t* St = (LAS bf16_t*)(lds + H_ST); LAS float* segtot2 = (LAS float*)(lds + H_SEG); LAS float* ssqb = (LAS float*)(lds + H_SSQ);
  const size_t tokbase = (size_t)b * SEQ + (size_t)nn * SCR;
  const int lfcol = (dir ? C_LFB : C_LFF) + h * 128;
  LAS float* gnl = (LAS float*)(lds + H_GN);
  if (OUT && dir == 1 && tid < 128) gnl[tid] = p.hg_gain[(size_t)l * 512 + h * 128 + tid];
  unsigned short lfr[16], vv[16], qr[16];
  const char* hbase = (const char*)(P + tokbase * NP + h * 128);
  const unsigned lfo = (unsigned)((dir ? C_LFB : C_LFF) * 2), iao = (unsigned)(C_IA * 2);
  const int rstep = dir ? -(NP * 2) : (NP * 2);
#define H_LOADS(CC) do { const int r0_ = (CC) * 64 + seg * 16; unsigned vo_ = (unsigned)((dir ? (SCR - 1) - r0_ : r0_) * (NP * 2) + d * 2); \
    _Pragma("unroll") for (int i = 0; i < 16; ++i) { const char* a_ = hbase + vo_; lfr[i] = *(const bf16_t*)(a_ + lfo); vv[i] = *(const bf16_t*)(a_ + iao); if (OUT) qr[i] = *(const bf16_t*)a_; vo_ += (unsigned)rstep; } } while (0)
  H_LOADS(0);
  for (int cc = 0; cc < NSUB; ++cc) {
    float lfv[16], loc[16], qv[16];
    float run = 0.f;
#pragma unroll
    for (int i = 0; i < 16; ++i) { lfv[i] = h2f(lfr[i]); if (OUT) qv[i] = bf2f(qr[i]); run += lfv[i]; loc[i] = run; }
    LAS float* segtot = segtot2 + (cc & 1) * 512;
    segtot[seg * 128 + d] = run;
    lds_barrier();
    {
      const float s0 = segtot[d], s1 = segtot[128 + d], s2 = segtot[256 + d], s3 = segtot[384 + d];
      const float bmid = s0 + s1, bend = bmid + s2 + s3;
      const float off = (seg > 0 ? s0 : 0.f) + (seg > 1 ? s1 : 0.f) + (seg > 2 ? s2 : 0.f);
      btot += bend;
      const float dof = off - bmid;
      unsigned ktw[8];
#pragma unroll
      for (int i = 0; i < 16; i += 2) {
        const float d0 = dof + loc[i], d1 = dof + loc[i + 1];
        const float k0 = 1.0f - __builtin_amdgcn_exp2f(lfv[i]), k1 = 1.0f - __builtin_amdgcn_exp2f(lfv[i + 1]);
        const unsigned kw = pk_bf16(k0 * __builtin_amdgcn_exp2f(fminf(-d0, 115.f)), k1 * __builtin_amdgcn_exp2f(fminf(-d1, 115.f)));
        ktw[i >> 1] = kw;
        if (OUT) { const int r = seg * 16 + i;
          const unsigned qw = pk_bf16(qv[i] * __builtin_amdgcn_exp2f(fminf(d0, 115.f)), qv[i + 1] * __builtin_amdgcn_exp2f(fminf(d1, 115.f)));
          Ks[r * H_QLD + d] = (bf16_t)(kw & 0xffffu); Ks[(r + 1) * H_QLD + d] = (bf16_t)(kw >> 16);
          Qs[r * H_QLD + d] = (bf16_t)(qw & 0xffffu); Qs[(r + 1) * H_QLD + d] = (bf16_t)(qw >> 16); }
      }
      u32x4 w0, w1;
      w0.x = ktw[0]; w0.y = ktw[1]; w0.z = ktw[2]; w0.w = ktw[3]; w1.x = ktw[4]; w1.y = ktw[5]; w1.z = ktw[6]; w1.w = ktw[7];
      *(LAS u32x4*)(KT + d * H_TLD + seg * 16) = w0; *(LAS u32x4*)(KT + d * H_TLD + seg * 16 + 8) = w1;
      w0.x = vv[0] | ((unsigned)vv[1] << 16); w0.y = vv[2] | ((unsigned)vv[3] << 16); w0.z = vv[4] | ((unsigned)vv[5] << 16); w0.w = vv[6] | ((unsigned)vv[7] << 16);
      w1.x = vv[8] | ((unsigned)vv[9] << 16); w1.y = vv[10] | ((unsigned)vv[11] << 16); w1.z = vv[12] | ((unsigned)vv[13] << 16); w1.w = vv[14] | ((unsigned)vv[15] << 16);
      *(LAS u32x4*)(Vt + d * H_TLD + seg * 16) = w0; *(LAS u32x4*)(Vt + d * H_TLD + seg * 16 + 8) = w1;
    }
    if (cc < NSUB - 1) H_LOADS(cc + 1);
    float e1[4], e2[4], em[4];
#pragma unroll
    for (int j = 0; j < 4; ++j) { const int dk = wid * 16 + fq * 4 + j; const float s0 = segtot[dk], s1 = segtot[128 + dk], s2 = segtot[256 + dk], s3 = segtot[384 + dk];
      em[j] = __builtin_amdgcn_exp2f(s0 + s1); e2[j] = __builtin_amdgcn_exp2f(s2 + s3); e1[j] = __builtin_amdgcn_exp2f(s0 + s1 + s2 + s3); }
    if (OUT) {
#pragma unroll
      for (int dvt = 0; dvt < 8; ++dvt) { u32x2 w; w.x = pk_bf16(S[dvt][0] * em[0], S[dvt][1] * em[1]); w.y = pk_bf16(S[dvt][2] * em[2], S[dvt][3] * em[3]);
        *(LAS u32x2*)(St + (dvt * 16 + fr) * H_QLD + wid * 16 + fq * 4) = w; }
    }
    lds_barrier();
    f32x4 oo[4];
    const int tt = wid & 3, dh = wid >> 2;
    u32x2 zzv[4]; unsigned long long ofv[4];
    if (OUT && dir == 1) {
      const int r = cc * 64 + tt * 16 + fr; const size_t tok = tokbase + (size_t)((SCR - 1) - r);
#pragma unroll
      for (int i = 0; i < 4; ++i) { const int col = h * 128 + dh * 64 + i * 16 + fq * 4;
        zzv[i] = *(const u32x2*)(P + tok * NP + C_ZA + col);
        ofv[i] = __hip_atomic_load((const unsigned long long*)(P + tok * NP + C_LFF + col), __ATOMIC_RELAXED, __HIP_MEMORY_SCOPE_AGENT); }
    }
    if (OUT) {
      bf16x8 qf[4];
#pragma unroll
      for (int kk = 0; kk < 4; ++kk) qf[kk] = *(const LAS bf16x8*)(Qs + (tt * 16 + fr) * H_QLD + kk * 32 + fq * 8);
      f32x4 pt[4];
#pragma unroll
      for (int st = 0; st < 4; ++st) {
        pt[st] = (f32x4){0.f, 0.f, 0.f, 0.f};
        if (st <= tt) {
          f32x4 a = {0.f, 0.f, 0.f, 0.f};
#pragma unroll
          for (int kk = 0; kk < 4; ++kk) { const bf16x8 kf = *(const LAS bf16x8*)(Ks + (st * 16 + fr) * H_QLD + kk * 32 + fq * 8); a = mfma16(kf, qf[kk], a); }
#pragma unroll
          for (int j = 0; j < 4; ++j) pt[st][j] = (st * 16 + fq * 4 + j <= tt * 16 + fr) ? a[j] : 0.f;
        }
      }
      bf16x8 pb[2];
#pragma unroll
      for (int pp = 0; pp < 2; ++pp) { u32x4 w; w.x = pk_bf16(pt[2 * pp][0], pt[2 * pp][1]); w.y = pk_bf16(pt[2 * pp][2], pt[2 * pp][3]); w.z = pk_bf16(pt[2 * pp + 1][0], pt[2 * pp + 1][1]); w.w = pk_bf16(pt[2 * pp + 1][2], pt[2 * pp + 1][3]);
        pb[pp] = __builtin_bit_cast(bf16x8, w); }
#pragma unroll
      for (int i = 0; i < 4; ++i) {
        const int dvt = dh * 4 + i; f32x4 a = {0.f, 0.f, 0.f, 0.f};
#pragma unroll
        for (int pp = 0; pp < 2; ++pp) if (2 * pp <= tt) {
          const bf16x4 v0 = *(const LAS bf16x4*)(Vt + (dvt * 16 + fr) * H_TLD + pp * 32 + fq * 4), v1 = *(const LAS bf16x4*)(Vt + (dvt * 16 + fr) * H_TLD + pp * 32 + 16 + fq * 4);
          const bf16x8 vf = {v0[0], v0[1], v0[2], v0[3], v1[0], v1[1], v1[2], v1[3]};
          a = mfma16(vf, pb[pp], a); }
#pragma unroll
        for (int kk = 0; kk < 4; ++kk) { const bf16x8 sf = *(const LAS bf16x8*)(St + (dvt * 16 + fr) * H_QLD + kk * 32 + fq * 8); a = mfma16(sf, qf[kk], a); }
        oo[i] = a;
      }
      const int r = cc * 64 + tt * 16 + fr; const size_t tok = tokbase + (dir ? (SCR - 1) - r : r);
      if (dir == 0) {
#pragma unroll
        for (int i = 0; i < 4; ++i) { u32x2 w; w.x = pk_bf16(oo[i][0], oo[i][1]); w.y = pk_bf16(oo[i][2], oo[i][3]);
          *(u32x2*)(P + tok * NP + C_LFF + h * 128 + dh * 64 + i * 16 + fq * 4) = w; }
      } else {
        float ss = 0.f;
#pragma unroll
        for (int i = 0; i < 4; ++i) {
          const unsigned long long ww = ofv[i];
          const unsigned lo = (unsigned)ww, hi = (unsigned)(ww >> 32);
          oo[i][0] += bflo(lo); oo[i][1] += bfhi(lo); oo[i][2] += bflo(hi); oo[i][3] += bfhi(hi);
          ss += (oo[i][0] * oo[i][0] + oo[i][1] * oo[i][1]) + (oo[i][2] * oo[i][2] + oo[i][3] * oo[i][3]);
        }
        ss += __shfl_xor(ss, 16); ss += __shfl_xor(ss, 32);
        if (fq == 0) ssqb[dh * 64 + tt * 16 + fr] = ss;
      }
    }
#pragma unroll
    for (int dvt = 0; dvt < 8; ++dvt) {
      f32x4 a = {0.f, 0.f, 0.f, 0.f};
#pragma unroll
      for (int kk = 0; kk < 2; ++kk) { const bf16x8 kf = *(const LAS bf16x8*)(KT + (wid * 16 + fr) * H_TLD + kk * 32 + fq * 8), vf = *(const LAS bf16x8*)(Vt + (dvt * 16 + fr) * H_TLD + kk * 32 + fq * 8);
        a = mfma16(kf, vf, a); }
#pragma unroll
      for (int j = 0; j < 4; ++j) S[dvt][j] = e1[j] * S[dvt][j] + e2[j] * a[j];
    }
    if (OUT && dir == 1) {
      lds_barrier();
      const int r = cc * 64 + tt * 16 + fr; const size_t tok = tokbase + (size_t)((SCR - 1) - r);
      const float tot = ssqb[tt * 16 + fr] + ssqb[64 + tt * 16 + fr];
      const float rs = rsqrtf(tot * (1.0f / 128.0f) + EPS);
#pragma unroll
      for (int i = 0; i < 4; ++i) {
        const int col = h * 128 + dh * 64 + i * 16 + fq * 4;
        const f32x4 gn = *(const LAS f32x4*)(gnl + dh * 64 + i * 16 + fq * 4);
        const u32x2 zz = zzv[i];
        u32x2 w; w.x = pk_bf16(oo[i][0] * rs * gn[0] * fsilu(bflo(zz.x)), oo[i][1] * rs * gn[1] * fsilu(bfhi(zz.x))); w.y = pk_bf16(oo[i][2] * rs * gn[2] * fsilu(bflo(zz.y)), oo[i][3] * rs * gn[3] * fsilu(bfhi(zz.y)));
        *(u32x2*)(P + tok * NP + C_QA + col) = w;
      }
    }
  }
}


#define XB_TMO      128
#define XB_XCNT(j)  (256  + 64 * (j))
#define XB_XSUB(j)  (1280 + 64 * (j))
#define XB_XGEN(j)  (2304 + 64 * (j))
#define XB_TOP      3328
#define XB_TOPGEN   3392
#define XCD_BAR_WORDS 3456
#define XB_SPIN_CAP (1u << 22)
DI unsigned xb_ld(unsigned* p) { return __hip_atomic_load(p, __ATOMIC_RELAXED, __HIP_MEMORY_SCOPE_AGENT); }
DI unsigned xb_add(unsigned* p, unsigned v) { return __hip_atomic_fetch_add(p, v, __ATOMIC_RELAXED, __HIP_MEMORY_SCOPE_AGENT); }
DI unsigned xb_xcc_id() { return (unsigned)__builtin_amdgcn_s_getreg((3 << 11) | 20) & 0xFu; }
#define XB_SPIN(cond, bar) do { unsigned _sp = 0; while (cond) { __builtin_amdgcn_s_sleep(1); \
    if ((++_sp & 255u) == 0u) { if (xb_ld(&(bar)[XB_TMO])) break; if (_sp > XB_SPIN_CAP) { atomicAdd(&(bar)[XB_TMO], 1u); break; } } } } while (0)
struct XcdBarrier { unsigned* bar; unsigned x; volatile LAS unsigned* st; };
DI XcdBarrier xcd_barrier_post(unsigned* bar, volatile LAS unsigned* st) {
  XcdBarrier b; b.bar = bar; b.x = xb_xcc_id(); b.st = st;
  if (threadIdx.x == 0) (void)xb_add(&bar[XB_XCNT(b.x)], 1u);
  return b;
}
DI void xcd_barrier_complete(unsigned* bar, unsigned x, unsigned& nloc, unsigned& nx) {
  const unsigned G = gridDim.x;
  unsigned sum, cnt, mine, sp = 0u;
  for (;;) {
    sum = 0u; cnt = 0u; mine = 0u;
#pragma unroll
    for (unsigned j = 0; j < 16; ++j) { const unsigned c = xb_ld(&bar[XB_XCNT(j)]); sum += c; cnt += (c > 0u) ? 1u : 0u; mine = (j == x) ? c : mine; }
    if (sum == G) break;
    __builtin_amdgcn_s_sleep(1);
    if ((++sp & 255u) == 0u) { if (xb_ld(&bar[XB_TMO])) break; if (sp > XB_SPIN_CAP) { atomicAdd(&bar[XB_TMO], 1u); break; } }
  }
  nloc = mine > 0u ? mine : 1u; nx = cnt > 0u ? cnt : 1u;
}
DI void xcd_barrier(const XcdBarrier& b) {
  asm volatile("s_waitcnt vmcnt(0)" ::: "memory");
  __syncthreads();
  if (threadIdx.x == 0) {
    unsigned* bar = b.bar;
    __builtin_amdgcn_s_waitcnt(0);
    unsigned nloc = b.st[0], nx = b.st[1];
    if (nloc == 0u) { xcd_barrier_complete(bar, b.x, nloc, nx); b.st[0] = nloc; b.st[1] = nx; }
    const unsigned old = xb_add(&bar[XB_XSUB(b.x)], 1u);
    const unsigned gen = old / nloc;
    if (old + 1u == (gen + 1u) * nloc) {
      __builtin_amdgcn_fence(__ATOMIC_RELEASE, "agent");
      asm volatile("s_waitcnt vmcnt(0)" ::: "memory");
      const unsigned og = xb_add(&bar[XB_TOP], 1u);
      const unsigned tg = og / nx;
      if (og + 1u == (tg + 1u) * nx) xb_add(&bar[XB_TOPGEN], 1u);
      else XB_SPIN(xb_ld(&bar[XB_TOPGEN]) == tg, bar);
      __builtin_amdgcn_fence(__ATOMIC_ACQUIRE, "agent");
      xb_add(&bar[XB_XGEN(b.x)], 1u);
      asm volatile("s_waitcnt vmcnt(0)" ::: "memory");
    } else {
      XB_SPIN(xb_ld(&bar[XB_XGEN(b.x)]) == gen, bar);
      __builtin_amdgcn_fence(__ATOMIC_ACQUIRE, "agent");
      asm volatile("s_waitcnt vmcnt(0)" ::: "memory");
    }
  }
  __syncthreads();
}
#ifndef PHM
#define PHM 0xffff
#endif
__global__ void __launch_bounds__(512, 2) fwd_mega(Params p) {
  extern __shared__ __attribute__((aligned(16))) unsigned char lds_raw[];
  LAS unsigned char* lds = (LAS unsigned char*)lds_raw;
  cg::grid_group grid = cg::this_grid();
  if (threadIdx.x < 4) ((LAS unsigned*)(lds + LDS_XB))[threadIdx.x] = 0u;
  __syncthreads();
  const XcdBarrier xbar = xcd_barrier_post((unsigned*)(p.ws + WS_BAR), (volatile LAS unsigned*)(lds + LDS_XB));
  const int G = gridDim.x, bid = blockIdx.x;
  const long gthreads = (long)G * 512;
#define LANEVARS const int tid = opaque_tid(); const int wid = __builtin_amdgcn_readfirstlane(tid >> 6), lane = tid & 63; const long gtid = (long)bid * 512 + tid; (void)wid; (void)lane; (void)gtid
  unsigned char* ws = p.ws;
  bf16_t* P = (bf16_t*)(ws + WS_PROJ); bf16_t* XB = (bf16_t*)(ws + WS_XB);
  bf16_t* WIN = (bf16_t*)(ws + WS_WIN); bf16_t* WG = (bf16_t*)(ws + WS_WG); bf16_t* WBR = (bf16_t*)(ws + WS_WBR); bf16_t* WOUT = (bf16_t*)(ws + WS_WOUT);
  float* ST = (float*)(ws + WS_ST); float* DD = (float*)(ws + WS_DD); float* SSQ = (float*)(ws + WS_SSQ);
  float* ROPE = (float*)(ws + WS_ROPE); float* LB = (float*)(ws + WS_LB);

  {
    LANEVARS;
    for (int r = (bid * 8 + wid) * 2; r < T_TOK; r += G * 16) {
      f32x4 v[2][4];
#pragma unroll
      for (int rr = 0; rr < 2; ++rr)
#pragma unroll
        for (int i = 0; i < 4; ++i) v[rr][i] = *(const f32x4*)(p.x + (size_t)(r + rr) * DM + i * 256 + lane * 4);
#pragma unroll
      for (int rr = 0; rr < 2; ++rr) {
        float ss = 0.f;
#pragma unroll
        for (int i = 0; i < 4; ++i) {
          u32x2 w; w.x = pk_bf16(v[rr][i][0], v[rr][i][1]); w.y = pk_bf16(v[rr][i][2], v[rr][i][3]);
          *(u32x2*)(XB + (size_t)(r + rr) * DM + i * 256 + lane * 4) = w;
          ss += (v[rr][i][0] * v[rr][i][0] + v[rr][i][1] * v[rr][i][1]) + (v[rr][i][2] * v[rr][i][2] + v[rr][i][3] * v[rr][i][3]);
        }
#pragma unroll
        for (int o = 32; o >= 1; o >>= 1) ss += __shfl_xor(ss, o);
        if (lane < 16) SSQ[(size_t)(r + rr) * 16 + lane] = lane == 0 ? ss : 0.f;
      }
    }
    for (long i = gtid; i < (long)SEQ * 32; i += gthreads) {
      const int pos = (int)(i >> 5), j = (int)(i & 31);
      const float invf = powf(10000.0f, -(float)j / 32.0f);
      const float ang = (float)pos * invf;
      double rev = (double)ang * 0.15915494309189535; rev -= floor(rev);
      ROPE[(size_t)pos * 64 + j] = __builtin_amdgcn_cosf((float)rev); ROPE[(size_t)pos * 64 + 32 + j] = __builtin_amdgcn_sinf((float)rev);
    }
    for (long i = gtid; i < 1024; i += gthreads) {
      const float a0 = p.lb_logits[i], a1 = p.lb_logits[1024 + i], a2 = p.lb_logits[2048 + i], a3 = p.lb_logits[3072 + i];
      const float mx = fmaxf(fmaxf(a0, a1), fmaxf(a2, a3));
      const float e0 = expf(a0 - mx), e1 = expf(a1 - mx), e2 = expf(a2 - mx), e3 = expf(a3 - mx); const float inv = 1.0f / (e0 + e1 + e2 + e3);
      LB[i] = 0.f; LB[1024 + i] = e1 * inv; LB[2048 + i] = (e1 + e2) * inv; LB[3072 + i] = (e1 + e2 + e3) * inv;
    }
    convert_w(p.w_in, NIN, DM, WIN, NP, 1, 0, p.norm_gain, gtid, gthreads);
  }
  if (p.use_cg_sync) grid.sync(); else xcd_barrier(xbar);

  for (int l = 0; l < DEPTH; ++l) {
    if (2 * bid >= G) { LANEVARS;
    const long ct = (long)(bid - (G + 1) / 2) * 512 + tid, cth = (long)(G - (G + 1) / 2) * 512;
    convert_w(p.w_in + (size_t)l * DM * NIN, NIN, DM, WG, 3072, 0, NP, p.norm_gain + l * DM, ct, cth);
    convert_w(p.wba + (size_t)l * 512 * DM, DM, 512, WBR, 1024, 0, 0, nullptr, ct, cth, 1.0f / 255.0f);
    convert_w(p.wbb + (size_t)l * 512 * DM, DM, 512, WBR + 1024 * 512, 1024, 0, 0, nullptr, ct, cth, 1.0f / 255.0f);
    convert_w(p.wbc + (size_t)l * 512 * DM, DM, 512, WBR + 2 * 1024 * 512, 1024, 0, 0, nullptr, ct, cth, 1.0f / 255.0f);
    convert_w(p.w_out + (size_t)l * DM * DM, DM, DM, WOUT, 1024, 0, 0, nullptr, ct, cth); }
    if (PHM & 1) {
      GenPlain gen{(const char*)XB, (const char*)WIN, DM * 2, DM * 2, 16, 128, NP / 256, G, bid};
      EpiProj epi{P, SSQ, LB + l * 1024};
      gemm_phase<1>(lds, gen, epi, SSQ);
    }
    xcd_barrier(xbar);
    if (l + 1 < DEPTH) { LANEVARS; convert_w(p.w_in + (size_t)(l + 1) * DM * NIN, NIN, DM, WIN, NP, 1, 0, p.norm_gain + (l + 1) * DM, gtid, gthreads); }
    if (PHM & 2) for (int item = bid; item < 256; item += G) sgu_item(lds, p, l, item);
    if (PHM & 4) for (int item = bid; item < 512; item += G) attn_item(lds, p, l, item);
    if (PHM & 8) for (int item = bid; item < 32 * NSC; item += G) {
      LANEVARS;
      const int seq = item / NSC, n = item % NSC, dir = seq & 1, bh = seq >> 1, b = bh >> 2, h = bh & 3; const int nn = dir ? NSC - 1 - n : n;
      f32x4 S[8];
#pragma unroll
      for (int i = 0; i < 8; ++i) S[i] = (f32x4){0.f, 0.f, 0.f, 0.f};
      float btot = 0.f;
      hgrn_super<false>(lds, p, l, b, h, nn, dir, S, btot);
      float* dst = ST + ((size_t)seq * NSC + n) * 16384;
      const int fr = lane & 15, fq = lane >> 4;
#pragma unroll
      for (int dvt = 0; dvt < 8; ++dvt)
#pragma unroll
        for (int j = 0; j < 4; ++j) dst[(wid * 16 + fq * 4 + j) * 128 + dvt * 16 + fr] = S[dvt][j];
      if (tid < 128) DD[((size_t)seq * NSC + n) * 128 + tid] = __builtin_amdgcn_exp2f(btot);
    }
    xcd_barrier(xbar);
    { LANEVARS;
    for (long e = gtid; e < 32L * 4096; e += gthreads) {
      const int seq = (int)(e >> 12), q4 = (int)(e & 4095); const int dk = q4 >> 5;
      float* base = ST + (size_t)seq * NSC * 16384 + (size_t)q4 * 4; const float* dbase = DD + (size_t)seq * NSC * 128 + dk;
      f32x4 carry = {0.f, 0.f, 0.f, 0.f};
      for (int nb = 0; nb < NSC; nb += 16) {
        f32x4 u[16]; float dc[16];
#pragma unroll
        for (int i = 0; i < 16; ++i) { u[i] = *(const f32x4*)(base + (size_t)(nb + i) * 16384); dc[i] = dbase[(nb + i) * 128]; }
#pragma unroll
        for (int i = 0; i < 16; ++i) { *(f32x4*)(base + (size_t)(nb + i) * 16384) = carry; carry = carry * dc[i] + u[i]; }
      }
    } }
    xcd_barrier(xbar);
    if (PHM & 16) for (int item = bid; item < 16 * NSC; item += G) {
      LANEVARS;
      const int nn = item % NSC, bh = item / NSC, b = bh >> 2, h = bh & 3;
      const int fr = lane & 15, fq = lane >> 4;
      for (int dir = 0; dir < 2; ++dir) {
        const int seq = bh * 2 + dir, n = dir ? NSC - 1 - nn : nn;
        const float* src = ST + ((size_t)seq * NSC + n) * 16384;
        f32x4 S[8];
#pragma unroll
        for (int dvt = 0; dvt < 8; ++dvt)
#pragma unroll
          for (int j = 0; j < 4; ++j) S[dvt][j] = src[(wid * 16 + fq * 4 + j) * 128 + dvt * 16 + fr];
        float btot = 0.f;
        hgrn_super<true>(lds, p, l, b, h, nn, dir, S, btot);
      }
    }
    xcd_barrier(xbar);
    if (PHM & 32) {
      GenMerge gen{(const char*)XB, (const char*)P, (const char*)WG, (const char*)WBR, G, bid};
      EpiMerge epi{P, SSQ, ws + WS_ST + (size_t)bid * 262144};
      gemm_phase<2>(lds, gen, epi, SSQ);
    }
    xcd_barrier(xbar);
    if (PHM & 64) {
      GenPlain gen{(const char*)(P + C_MERGED), (const char*)WOUT, NP * 2, DM * 2, 16, 128, 4, G, bid};
      EpiOut epi{p.x, p.out, XB, SSQ, l == 0 ? 1 : 0, l == DEPTH - 1 ? 1 : 0};
      gemm_phase<0>(lds, gen, epi, SSQ);
    }
    if (l + 1 < DEPTH) xcd_barrier(xbar);
  }
}

extern "C" void kernel_launch(void* const* d_in, const int* in_sizes, int n_in, void* d_out, int out_size,
                              void* d_ws, size_t ws_size, hipStream_t stream) {
  static int grid_blocks = 0;
  if (!grid_blocks) {
    int dev = 0, cus = 0, per_cu = 0;
    (void)hipGetDevice(&dev);
    (void)hipDeviceGetAttribute(&cus, hipDeviceAttributeMultiprocessorCount, dev);
    (void)hipFuncSetAttribute((const void*)fwd_mega, hipFuncAttributeMaxDynamicSharedMemorySize, LDS_BYTES);
    (void)hipOccupancyMaxActiveBlocksPerMultiprocessor(&per_cu, (const void*)fwd_mega, 512, LDS_BYTES);
    (void)hipGetLastError();
    grid_blocks = cus > 0 ? cus : 256;
    if (ws_size < WS_END) { fprintf(stderr, "workspace too small: %zu < %zu\n", ws_size, (size_t)WS_END); grid_blocks = -1; }
  }
  if (grid_blocks < 0) return;
  Params p{};
  p.x = (const float*)d_in[0]; p.w_in = (const float*)d_in[1]; p.norm_gain = (const float*)d_in[2]; p.lb_logits = (const float*)d_in[3];
  p.hg_gain = (const float*)d_in[4]; p.sg_g = (const float*)d_in[5]; p.sg_b = (const float*)d_in[6]; p.w_sp = (const float*)d_in[7];
  p.b_sp = (const float*)d_in[8]; p.qg = (const float*)d_in[9]; p.kg = (const float*)d_in[10]; p.sink = (const float*)d_in[11];
  p.wba = (const float*)d_in[12]; p.wbb = (const float*)d_in[13]; p.wbc = (const float*)d_in[14]; p.w_out = (const float*)d_in[15];
  p.out = (float*)d_out; p.ws = (unsigned char*)d_ws;
  (void)hipMemsetAsync((unsigned char*)d_ws + WS_BAR, 0, 3456 * 4, stream);
  void* args[] = {&p};
  hipError_t e = hipLaunchCooperativeKernel((const void*)fwd_mega, dim3(grid_blocks), dim3(512), args, LDS_BYTES, stream);
  if (e != hipSuccess) fprintf(stderr, "cooperative launch failed: %s (grid %d)\n", hipGetErrorString(e), grid_blocks);
}
```
